# Optimizing an MI355X kernel written in HIP

```python
import jax
import jax.numpy as jnp
from jax import lax
import numpy as np

D_MODEL = 4096
BATCH = 2
SEQ = 8192
DEPTH = 2

HEAD_DIM = 128
MIX_HEADS = D_MODEL // HEAD_DIM
QBLOCK = 128
ROPE_THETA = 10000.0
LN_EPS = 1e-5
RMS_EPS = 1e-6

SB_HEADS = MIX_HEADS // 4
DIL_HEADS = MIX_HEADS // 4
DIL_BRANCHES = ((128, 1), (512, 4), (2048, 16))
MLA_HEADS = MIX_HEADS // 4
MLA_Q_RANK = D_MODEL // 4
MLA_KV_RANK = 512
MLA_NOPE = 128
MLA_ROPE = 64
MLA_V = 128
DIFF_HEADS = MIX_HEADS // 8
DIFF_DIM = HEAD_DIM
D_FF = 4 * D_MODEL
PLE_DIM = 256
DN_ALPHA = (2 * DEPTH) ** 0.25
DN_BETA = (8 * DEPTH) ** -0.25

IN_WIDTHS = (SB_HEADS * HEAD_DIM,) * 3 + (DIL_HEADS * HEAD_DIM,) * 3 + (MLA_Q_RANK, MLA_KV_RANK, MLA_ROPE) + (DIFF_HEADS * 2 * DIFF_DIM,) * 3
N_IN = sum(IN_WIDTHS)
MIX_OUT = SB_HEADS * HEAD_DIM + DIL_HEADS * HEAD_DIM + MLA_HEADS * MLA_V + DIFF_HEADS * 2 * DIFF_DIM

kernel_name = 'hybrid_parallel_heads_deepnorm'


def layer_norm(x, g, b):
    xf = x.astype(jnp.float32)
    mu = jnp.mean(xf, axis=-1, keepdims=True)
    var = jnp.mean(jnp.square(xf - mu), axis=-1, keepdims=True)
    return ((xf - mu) * lax.rsqrt(var + LN_EPS) * g + b).astype(x.dtype)


def rms_norm(x, g):
    xf = x.astype(jnp.float32)
    return (xf * lax.rsqrt(jnp.mean(jnp.square(xf), axis=-1, keepdims=True) + RMS_EPS) * g).astype(x.dtype)


def rope(x, pos):
    half = x.shape[-1] // 2
    inv = ROPE_THETA ** (-jnp.arange(half, dtype=jnp.float32) / half)
    ang = pos.astype(jnp.float32)[:, None] * inv[None, :]
    cos, sin = jnp.cos(ang), jnp.sin(ang)
    x1 = x[..., :half].astype(jnp.float32)
    x2 = x[..., half:].astype(jnp.float32)
    return jnp.concatenate([x1 * cos - x2 * sin, x2 * cos + x1 * sin], axis=-1).astype(x.dtype)


def _heads(t, n_heads):
    B, S, _ = t.shape
    return t.reshape(B, S, n_heads, -1).transpose(0, 2, 1, 3)


def _merge(t):
    B, H, S, d = t.shape
    return t.transpose(0, 2, 1, 3).reshape(B, S, H * d)


def over_query_blocks(block_fn, *qs):
    B, H, S, _ = qs[0].shape
    nb = S // QBLOCK
    blks = tuple(q.reshape(B, H, nb, QBLOCK, q.shape[-1]).transpose(2, 0, 1, 3, 4) for q in qs)
    starts = jnp.arange(nb, dtype=jnp.int32) * QBLOCK
    out = lax.map(lambda a: block_fn(a[0] + jnp.arange(QBLOCK, dtype=jnp.int32), *a[1:]), (starts,) + blks)
    return out.transpose(1, 2, 0, 3, 4).reshape(B, H, S, out.shape[-1])


def stick_breaking_attention(q, k, v):
    S = k.shape[2]
    kpos = jnp.arange(S, dtype=jnp.int32)
    scale = HEAD_DIM ** -0.5

    def block(qpos, qb):
        z = jnp.einsum('bhqd,bhkd->bhqk', qb, k).astype(jnp.float32) * scale
        past = kpos[None, :] < qpos[:, None]
        log_beta = jax.nn.log_sigmoid(z)
        log_1m = jnp.where(past, log_beta - z, 0.0)
        between = lax.cumsum(log_1m, axis=3, reverse=True) - log_1m
        w = jnp.where(past, jnp.exp(log_beta + between), 0.0)
        return jnp.einsum('bhqk,bhkd->bhqd', w.astype(v.dtype), v)

    return over_query_blocks(block, q)


def _dilated_branch(q, k, v, span, dil):
    B, H, S, dh = q.shape
    L = S // dil
    nb = -(-L // QBLOCK)
    Lp = nb * QBLOCK

    def strided(t):
        t = t.reshape(B, H, L, dil, dh).transpose(0, 1, 3, 2, 4)
        t = jnp.pad(t, ((0, 0), (0, 0), (0, 0), (0, Lp - L), (0, 0)))
        return t.reshape(B, H, dil, nb, QBLOCK, dh)

    def with_prev(t):
        prev = jnp.pad(t[:, :, :, :-1], ((0, 0), (0, 0), (0, 0), (1, 0), (0, 0), (0, 0)))
        return jnp.concatenate([prev, t], axis=4)

    qs = strided(q)
    kk = with_prev(strided(k))
    vv = with_prev(strided(v))
    s = jnp.einsum('bhrnqd,bhrnkd->bhrnqk', qs, kk).astype(jnp.float32) * HEAD_DIM ** -0.5
    dist = jnp.arange(QBLOCK)[:, None] + QBLOCK - jnp.arange(2 * QBLOCK)[None, :]
    in_band = (dist >= 0) & (dist <= span)
    missing = (jnp.arange(nb)[:, None, None] == 0) & (jnp.arange(2 * QBLOCK) < QBLOCK)[None, None, :]
    valid = in_band[None] & jnp.logical_not(missing)
    s = jnp.where(valid, s, -jnp.inf)
    m = jnp.max(s, axis=-1, keepdims=True)
    e = jnp.exp(s - m)
    den = jnp.sum(e, axis=-1)
    o = jnp.einsum('bhrnqk,bhrnkd->bhrnqd', e, vv.astype(jnp.float32)) / den[..., None]
    lse = m[..., 0] + jnp.log(den)
    o = o.reshape(B, H, dil, Lp, dh)[:, :, :, :L].transpose(0, 1, 3, 2, 4).reshape(B, H, S, dh)
    lse = lse.reshape(B, H, dil, Lp)[..., :L].transpose(0, 1, 3, 2).reshape(B, H, S)
    return o, lse


def dilated_attention(q, k, v):
    outs, lses = [], []
    for window, dil in DIL_BRANCHES:
        o, lse = _dilated_branch(q, k, v, window // dil, dil)
        outs.append(o)
        lses.append(lse)
    w = jax.nn.softmax(jnp.stack(lses), axis=0)
    return jnp.sum(w[..., None] * jnp.stack(outs), axis=0).astype(q.dtype)


def causal_softmax_attention(q, k, v, scale):
    kpos = jnp.arange(k.shape[2], dtype=jnp.int32)

    def block(qpos, qb):
        s = jnp.einsum('bhqd,bhkd->bhqk', qb, k).astype(jnp.float32) * scale
        p = jax.nn.softmax(jnp.where(kpos[None, :] <= qpos[:, None], s, -jnp.inf), axis=-1)
        return jnp.einsum('bhqk,bhkd->bhqd', p.astype(v.dtype), v)

    return over_query_blocks(block, q)


def mla(c_q, c_kv, k_rope_in, pos, q_norm_g, w_uq, kv_norm_g, w_ukv):
    B, S, _ = c_q.shape
    q = _heads(rms_norm(c_q, q_norm_g) @ w_uq, MLA_HEADS)
    q = jnp.concatenate([q[..., :MLA_NOPE], rope(q[..., MLA_NOPE:], pos)], axis=-1)
    kv = _heads(rms_norm(c_kv, kv_norm_g) @ w_ukv, MLA_HEADS)
    k_nope, v = kv[..., :MLA_NOPE], kv[..., MLA_NOPE:]
    k_rope = jnp.broadcast_to(rope(k_rope_in, pos)[:, None], (B, MLA_HEADS, S, MLA_ROPE))
    k = jnp.concatenate([k_nope, k_rope], axis=-1)
    return causal_softmax_attention(q, k, v, (MLA_NOPE + MLA_ROPE) ** -0.5)


def diff_attention(q, k, v, pos, lam_params, subln_g, lam_init):
    B, S, _ = q.shape

    def pair(t):
        t = t.reshape(B, S, DIFF_HEADS, 2, DIFF_DIM).transpose(0, 3, 2, 1, 4)
        return rope(t[:, 0], pos), rope(t[:, 1], pos)

    q1, q2 = pair(q)
    k1, k2 = pair(k)
    vh = _heads(v, DIFF_HEADS)
    lp = lam_params.astype(jnp.float32)
    lam = jnp.exp(jnp.sum(lp[0] * lp[1])) - jnp.exp(jnp.sum(lp[2] * lp[3])) + lam_init
    scale = DIFF_DIM ** -0.5
    kpos = jnp.arange(S, dtype=jnp.int32)

    def block(qpos, q1b, q2b):
        causal = kpos[None, :] <= qpos[:, None]

        def probs(qb, kb):
            s = jnp.einsum('bhqd,bhkd->bhqk', qb, kb).astype(jnp.float32) * scale
            return jax.nn.softmax(jnp.where(causal, s, -jnp.inf), axis=-1)

        a = probs(q1b, k1) - lam * probs(q2b, k2)
        return jnp.einsum('bhqk,bhkd->bhqd', a.astype(vh.dtype), vh)

    o = over_query_blocks(block, q1, q2)
    return rms_norm(o, subln_g) * (1.0 - lam_init)


def hybrid_layer(x, p_i, layer_idx, w_in, w_o, mla_q_norm, mla_w_uq, mla_kv_norm, mla_w_ukv,
                 diff_lambda, diff_subln, ln_attn_g, ln_attn_b, w_ff1, w_ff2, ln_ff_g, ln_ff_b,
                 w_ple_gate, w_ple_proj, ln_ple_g, ln_ple_b):
    S = x.shape[1]
    pos = jnp.arange(S, dtype=jnp.int32)
    h = x @ w_in
    cuts, acc = [], 0
    for wdt in IN_WIDTHS[:-1]:
        acc += wdt
        cuts.append(acc)
    (a_q, a_k, a_v, b_q, b_k, b_v, c_q, c_kv, c_kr, d_q, d_k, d_v) = jnp.split(h, cuts, axis=-1)

    y_a = stick_breaking_attention(_heads(a_q, SB_HEADS), _heads(a_k, SB_HEADS), _heads(a_v, SB_HEADS))
    y_b = dilated_attention(rope(_heads(b_q, DIL_HEADS), pos), rope(_heads(b_k, DIL_HEADS), pos), _heads(b_v, DIL_HEADS))
    y_c = mla(c_q, c_kv, c_kr, pos, mla_q_norm, mla_w_uq, mla_kv_norm, mla_w_ukv)
    lam_init = 0.8 - 0.6 * float(np.exp(-0.3 * layer_idx))
    y_d = diff_attention(d_q, d_k, d_v, pos, diff_lambda, diff_subln, lam_init)

    mix = jnp.concatenate([_merge(y_a), _merge(y_b), _merge(y_c), _merge(y_d)], axis=-1) @ w_o
    x = layer_norm(DN_ALPHA * x + mix, ln_attn_g, ln_attn_b)

    f = jnp.square(jax.nn.relu(x @ w_ff1)) @ w_ff2
    x = layer_norm(DN_ALPHA * x + f, ln_ff_g, ln_ff_b)

    e = jax.nn.sigmoid(x @ w_ple_gate) * (p_i @ w_ple_proj)
    return layer_norm(DN_ALPHA * x + e, ln_ple_g, ln_ple_b)


def setup_inputs(seed: int = 0) -> dict:
    key = jax.random.key(seed)
    ks = jax.random.split(key, 20)
    f32 = jnp.float32

    def nrm(k, shape, scale):
        return jax.random.normal(k, shape, f32) * scale

    def gain(k, shape):
        return 1.0 + 0.02 * jax.random.normal(k, shape, f32)

    L = DEPTH
    return {
        'x': nrm(ks[0], (BATCH, SEQ, D_MODEL), 1.0),
        'p': nrm(ks[1], (DEPTH, BATCH, SEQ, PLE_DIM), 1.0),
        'w_in': nrm(ks[2], (L, D_MODEL, N_IN), D_MODEL ** -0.5),
        'w_o': nrm(ks[3], (L, MIX_OUT, D_MODEL), DN_BETA * MIX_OUT ** -0.5),
        'mla_q_norm': gain(ks[4], (L, MLA_Q_RANK)),
        'mla_w_uq': nrm(ks[5], (L, MLA_Q_RANK, MLA_HEADS * (MLA_NOPE + MLA_ROPE)), MLA_Q_RANK ** -0.5),
        'mla_kv_norm': gain(ks[6], (L, MLA_KV_RANK)),
        'mla_w_ukv': nrm(ks[7], (L, MLA_KV_RANK, MLA_HEADS * (MLA_NOPE + MLA_V)), MLA_KV_RANK ** -0.5),
        'diff_lambda': nrm(ks[8], (L, 4, DIFF_DIM), 0.1),
        'diff_subln': gain(ks[9], (L, 2 * DIFF_DIM)),
        'ln_attn_g': gain(ks[10], (L, D_MODEL)),
        'ln_attn_b': nrm(ks[11], (L, D_MODEL), 0.02),
        'w_ff1': nrm(ks[12], (L, D_MODEL, D_FF), D_MODEL ** -0.5),
        'w_ff2': nrm(ks[13], (L, D_FF, D_MODEL), DN_BETA * D_FF ** -0.5),
        'ln_ff_g': gain(ks[14], (L, D_MODEL)),
        'ln_ff_b': nrm(ks[15], (L, D_MODEL), 0.02),
        'w_ple_gate': nrm(ks[16], (L, D_MODEL, D_MODEL), D_MODEL ** -0.5),
        'w_ple_proj': nrm(ks[17], (L, PLE_DIM, D_MODEL), DN_BETA * PLE_DIM ** -0.5),
        'ln_ple_g': gain(ks[18], (L, D_MODEL)),
        'ln_ple_b': nrm(ks[19], (L, D_MODEL), 0.02),
    }


def reference(x, p, w_in, w_o, mla_q_norm, mla_w_uq, mla_kv_norm, mla_w_ukv, diff_lambda, diff_subln,
              ln_attn_g, ln_attn_b, w_ff1, w_ff2, ln_ff_g, ln_ff_b, w_ple_gate, w_ple_proj, ln_ple_g, ln_ple_b):
    for i in range(DEPTH):
        x = hybrid_layer(x, p[i], i, w_in[i], w_o[i], mla_q_norm[i], mla_w_uq[i], mla_kv_norm[i], mla_w_ukv[i],
                         diff_lambda[i], diff_subln[i], ln_attn_g[i], ln_attn_b[i], w_ff1[i], w_ff2[i],
                         ln_ff_g[i], ln_ff_b[i], w_ple_gate[i], w_ple_proj[i], ln_ple_g[i], ln_ple_b[i])
    return x
```

```cpp
#include <hip/hip_runtime.h>
#include <cstdio>
#include <cstdint>
namespace pg8 {
#define PG8_LAS __attribute__((address_space(3)))
typedef unsigned short bf16_t;
typedef short bf16x8 __attribute__((ext_vector_type(8)));
typedef float f32x4 __attribute__((ext_vector_type(4)));
typedef unsigned u32x4 __attribute__((ext_vector_type(4)));
constexpr int BM = 256, BK = 64, HALF = 128, HTB = HALF * BK * 2  , STAGE_BYTES = 8 * HTB, NXCD = 8, WGM = 8;

__host__ __device__ __forceinline__ int lds_byte(int r, int c) { const int st = (r >> 4) * 2 + (c >> 5), rr = r & 15, cc = c & 31, ob = rr * 64 + cc * 2; return st * 1024 + (ob ^ (((ob >> 9) & 1) << 5)); }
__host__ __device__ __forceinline__ void stage_rc(int b, int& R, int& C) { const int st = b / 1024, sb = b % 1024, swz = sb ^ (((sb >> 9) & 1) << 5); R = (st >> 1) * 16 + swz / 64; C = (st & 1) * 32 + (swz % 64) / 2; }
__host__ __device__ __forceinline__ int perm32(int rho) { const int n = rho >> 4, i = rho & 15; return 8 * (i >> 2) + 4 * n + (i & 3); }

struct Unit { int pm, pn; };
struct Gemm { const bf16_t* A; const bf16_t* Bt; int M, N, K, lda; };

struct StaticOrder {
    int nM, nN, nwg, G, c;
    __host__ __device__ void init(int M, int N, int G_, int c_) { nM = M / BM; nN = N / BM; nwg = nM * nN; G = G_; c = c_; }
    __host__ __device__ bool next(int i, Unit& u) const {
        const long L = (long)i * G + c; if (L >= nwg) return false;
        int wgid = (int)L; { const int q = nwg / NXCD, r = nwg % NXCD, xcd = wgid % NXCD, off = wgid / NXCD; wgid = (xcd < r ? xcd * (q + 1) : r * (q + 1) + (xcd - r) * q) + off; }
        const int nig = WGM * nN, gid = wgid / nig, fm = gid * WGM, gsz = (nM - fm) < WGM ? (nM - fm) : WGM;
        u.pm = fm + ((wgid % nig) % gsz); u.pn = (wgid % nig) / gsz; return true;
    }
    __device__ __forceinline__ void a_ready(const Unit&) const {}
    __device__ __forceinline__ void done(const Unit&) const {}
};

__device__ __forceinline__ unsigned cvt_pk_bf16(float lo, float hi) { unsigned r; asm volatile("v_cvt_pk_bf16_f32 %0, %1, %2" : "=v"(r) : "v"(lo), "v"(hi)); return r; }
typedef float f32x2 __attribute__((ext_vector_type(2)));
__device__ __forceinline__ f32x2 gelu_pk(f32x2 v) {
    const f32x2 av = __builtin_elementwise_abs(v), d = av * 0.2316418882f + 1.0f;
    f32x2 t; t.x = __builtin_amdgcn_rcpf(d.x); t.y = __builtin_amdgcn_rcpf(d.y);
    f32x2 q = t * 0.5307027145f + (-0.7265760135f); q = q * t + 0.7107068705f; q = q * t + (-0.142248368f); q = q * t + 0.127414796f; q = q * t;
    const f32x2 s = (v * v) * (-0.72134752044f);
    f32x2 e; e.x = __builtin_amdgcn_exp2f(s.x); e.y = __builtin_amdgcn_exp2f(s.y);
    const f32x2 m = v * (q * e), r = v - m;
    f32x2 o; o.x = v.x < 0.f ? m.x : r.x; o.y = v.y < 0.f ? m.y : r.y; return o;
}

template <int ACT  > struct EpiBf16 {
    static constexpr bool PERM = true, AFTER_DRAIN = false; static_assert(ACT == 0 || ACT == 1, "EpiBf16: ACT is 0 (none) or 1 (gelu_pk)");
    bf16_t* O; int ldc; const float* bias; int split_cols; size_t split_stride; float scale0;
    __device__ __forceinline__ void operator()(const f32x4 (&acc)[2][2][4][2], const Unit& u, int wr, int wc, int fr, int fq) const {
        const int row0 = u.pm * BM + wr * 64 + fr; int colt = u.pn * BM; bf16_t* base = O;
        float sc = 1.f; if (split_cols) { const int t = colt / split_cols; base += (size_t)t * split_stride; colt -= t * split_cols; if (t == 0) sc = scale0; }
        const int col0 = colt + wc * 32 + 8 * fq, bcol0 = u.pn * BM + wc * 32 + 8 * fq;
        f32x4 bv[2][2];
#pragma unroll
        for (int bj = 0; bj < 2; ++bj)
#pragma unroll
            for (int n = 0; n < 2; ++n) bv[bj][n] = bias ? *(const f32x4*)(bias + bcol0 + bj * HALF + 4 * n) : (f32x4){0.f, 0.f, 0.f, 0.f};
#pragma unroll
        for (int ai = 0; ai < 2; ++ai)
#pragma unroll
            for (int m = 0; m < 4; ++m) { bf16_t* rowp = base + (size_t)(row0 + ai * HALF + m * 16) * ldc + col0;
#pragma unroll
                for (int bj = 0; bj < 2; ++bj) { f32x4 v0 = acc[ai][bj][m][0] + bv[bj][0], v1 = acc[ai][bj][m][1] + bv[bj][1];
                    if (ACT == 1) { f32x2 a = gelu_pk((f32x2){v0[0], v0[1]}), b = gelu_pk((f32x2){v0[2], v0[3]}), c = gelu_pk((f32x2){v1[0], v1[1]}), d = gelu_pk((f32x2){v1[2], v1[3]});
                        v0 = (f32x4){a.x, a.y, b.x, b.y}; v1 = (f32x4){c.x, c.y, d.x, d.y}; }
                    v0 = v0 * sc; v1 = v1 * sc; u32x4 w; w.x = cvt_pk_bf16(v0[0], v0[1]); w.y = cvt_pk_bf16(v0[2], v0[3]); w.z = cvt_pk_bf16(v1[0], v1[1]); w.w = cvt_pk_bf16(v1[2], v1[3]);
                    *(u32x4*)(rowp + bj * HALF) = w; } }
    }
};

struct PanelStats {
    unsigned* xbuf;
    unsigned* cnt;
    unsigned* tmo;
    int ntn; float eps;
    unsigned code;
    __device__ __forceinline__ bool run(const f32x4 (&v)[2][2][4][2], const Unit& u, int wr, int wc, int fr, int fq, PG8_LAS unsigned char* lds, int wid, int lane) const {
        typedef float f32x2v __attribute__((ext_vector_type(2)));
        PG8_LAS f32x2v* P = (PG8_LAS f32x2v*)lds;
        PG8_LAS f32x2v* S = (PG8_LAS f32x2v*)(lds + 8192);
        PG8_LAS unsigned* flag = (PG8_LAS unsigned*)(lds + 8192 + 2048);
#pragma unroll
        for (int ai = 0; ai < 2; ++ai)
#pragma unroll
            for (int m = 0; m < 4; ++m) {
                float s = 0.f;
#pragma unroll
                for (int bj = 0; bj < 2; ++bj)
#pragma unroll
                    for (int n = 0; n < 2; ++n) { const f32x4 x = v[ai][bj][m][n]; s += (x[0] + x[1]) + (x[2] + x[3]); }
                s += __shfl_xor(s, 16); s += __shfl_xor(s, 32);
                const float mw = s * (1.0f / 64.0f); float q = 0.f;
#pragma unroll
                for (int bj = 0; bj < 2; ++bj)
#pragma unroll
                    for (int n = 0; n < 2; ++n) { const f32x4 d = v[ai][bj][m][n] - mw; q += (d[0] * d[0] + d[1] * d[1]) + (d[2] * d[2] + d[3] * d[3]); }
                q += __shfl_xor(q, 16); q += __shfl_xor(q, 32);
                if (fq == 0) P[(ai * HALF + wr * 64 + m * 16 + fr) * 4 + wc] = (f32x2v){mw, q};
            }
        asm volatile("s_waitcnt lgkmcnt(0)" ::: "memory"); __builtin_amdgcn_s_barrier(); asm volatile("" ::: "memory");
#if defined(BROKEN_EXCHANGE_NO_WAIT)
#warning BROKEN CONTROL BUILD: the row-statistics exchange does not wait; results are wrong by design
        if (blockIdx.x >= 64) { const long long t0_ = clock64(); while (clock64() - t0_ < 60000) __builtin_amdgcn_s_sleep(8); }
#endif
        const int row = wid * 32 + (lane & 31);
        if (lane < 32) {
            const f32x2v a = P[row * 4 + 0], b = P[row * 4 + 1], c = P[row * 4 + 2], d = P[row * 4 + 3];
            const float mt = (a.x + b.x + c.x + d.x) * 0.25f;
            const float da = a.x - mt, db = b.x - mt, dc = c.x - mt, dd = d.x - mt;
            const float m2 = (a.y + b.y) + (c.y + d.y) + 64.0f * ((da * da + db * db) + (dc * dc + dd * dd));
            unsigned long long* slot = (unsigned long long*)xbuf + ((size_t)(u.pm * BM + row) * 4 + u.pn);
            __hip_atomic_store(slot, ((unsigned long long)__float_as_uint(m2) << 32) | __float_as_uint(mt), __ATOMIC_RELAXED, __HIP_MEMORY_SCOPE_AGENT);
        }
        asm volatile("s_waitcnt vmcnt(0)" ::: "memory");
        if (lane == 0) __hip_atomic_fetch_add(cnt + 64 * u.pm, 1u, __ATOMIC_RELAXED, __HIP_MEMORY_SCOPE_AGENT);
        if (wid == 0) {
            bool dead = false; const unsigned long long t0 = __builtin_amdgcn_s_memrealtime(); const unsigned want = 8u * (unsigned)ntn;
            for (;;) {
#if defined(BROKEN_EXCHANGE_NO_WAIT)
                break;
#endif
                if ((unsigned)__builtin_amdgcn_readfirstlane(__hip_atomic_load(cnt + 64 * u.pm, __ATOMIC_RELAXED, __HIP_MEMORY_SCOPE_AGENT)) >= want) break;
                if (__builtin_amdgcn_s_memrealtime() - t0 > 2000000ull) {
                    if (lane == 0) { unsigned expect = 0u; __hip_atomic_compare_exchange_strong(tmo + 1, &expect, code | (unsigned)(u.pm & 0xff), __ATOMIC_RELAXED, __ATOMIC_RELAXED, __HIP_MEMORY_SCOPE_AGENT);
                                     __hip_atomic_store(tmo, 1u, __ATOMIC_RELAXED, __HIP_MEMORY_SCOPE_AGENT); }
                    dead = true; break; }
                __builtin_amdgcn_s_sleep(2);
            }
            __builtin_amdgcn_fence(__ATOMIC_ACQUIRE, "agent");
            if (lane == 0) flag[0] = dead ? 1u : 0u;
        }
        asm volatile("s_waitcnt vmcnt(0) lgkmcnt(0)" ::: "memory"); __builtin_amdgcn_s_barrier(); asm volatile("" ::: "memory");
        const bool bad = flag[0] != 0u;
        if (lane < 32) {
            const unsigned long long* slot = (const unsigned long long*)xbuf + (size_t)(u.pm * BM + row) * 4; float mt[4], m2[4]; float ms = 0.f;
#pragma unroll
            for (int t = 0; t < 4; ++t) { if (t < ntn) { const unsigned long long w = __hip_atomic_load(slot + t, __ATOMIC_RELAXED, __HIP_MEMORY_SCOPE_AGENT); mt[t] = __uint_as_float((unsigned)w); m2[t] = __uint_as_float((unsigned)(w >> 32)); } else { mt[t] = 0.f; m2[t] = 0.f; } ms += mt[t]; }
            const float mean = ms / (float)ntn; float q = 0.f;
#pragma unroll
            for (int t = 0; t < 4; ++t) if (t < ntn) { const float dm = mt[t] - mean; q += m2[t] + 256.0f * dm * dm; }
            S[row] = (f32x2v){mean, 1.0f / sqrtf(q / (256.0f * (float)ntn) + eps)};
        }
        asm volatile("s_waitcnt lgkmcnt(0)" ::: "memory"); __builtin_amdgcn_s_barrier(); asm volatile("" ::: "memory");
        return bad;
    }
};
struct EpiLnRes {
    static constexpr bool PERM = false, AFTER_DRAIN = true;
    const float* base; float* out; int ldc; const float* bias; PanelStats st; unsigned poison;
    __device__ __forceinline__ void fused(f32x4 (&acc)[2][2][4][2], const Unit& u, int wr, int wc, int fr, int fq, PG8_LAS unsigned char* lds, int wid, int lane) const {
        typedef float f32x2v __attribute__((ext_vector_type(2)));
        const PG8_LAS f32x2v* S = (const PG8_LAS f32x2v*)(lds + 8192);
        const int col0 = u.pn * BM + wc * 32 + 4 * fq;
#pragma unroll
        for (int bj = 0; bj < 2; ++bj)
#pragma unroll
            for (int n = 0; n < 2; ++n) { const f32x4 bv = bias ? *(const f32x4*)(bias + col0 + bj * HALF + n * 16) : (f32x4){0.f, 0.f, 0.f, 0.f};
#pragma unroll
                for (int ai = 0; ai < 2; ++ai)
#pragma unroll
                    for (int m = 0; m < 4; ++m) acc[ai][bj][m][n] += bv; }
        f32x4 pre[4][2][2];
#pragma unroll
        for (int m = 0; m < 4; ++m) { const size_t off = (size_t)(u.pm * BM + wr * 64 + m * 16 + fr) * ldc + col0;
#pragma unroll
            for (int bj = 0; bj < 2; ++bj)
#pragma unroll
                for (int n = 0; n < 2; ++n) pre[m][bj][n] = *(const f32x4*)(base + off + bj * HALF + n * 16); }
        const bool bad = st.run(acc, u, wr, wc, fr, fq, lds, wid, lane) || poison != 0u;
        const float qnan = __builtin_nanf("");
#pragma unroll
        for (int ai = 0; ai < 2; ++ai)
#pragma unroll
            for (int m = 0; m < 4; ++m) { const int r = ai * HALF + wr * 64 + m * 16 + fr; const f32x2v sr = S[r]; const size_t off = (size_t)(u.pm * BM + r) * ldc + col0;
#pragma unroll
                for (int bj = 0; bj < 2; ++bj)
#pragma unroll
                    for (int n = 0; n < 2; ++n) { const f32x4 bs = ai == 0 ? pre[m][bj][n] : *(const f32x4*)(base + off + bj * HALF + n * 16); f32x4 o = bs + (acc[ai][bj][m][n] - sr.x) * sr.y;
                        if (bad) o = (f32x4){qnan, qnan, qnan, qnan}; *(f32x4*)(out + off + bj * HALF + n * 16) = o; }
                if (m & 1) asm volatile("" ::: "memory"); }
    }
};
struct EpiLnResLn {
    static constexpr bool PERM = false, AFTER_DRAIN = true;
    const float* base; float* out; bf16_t* xn; int ldc; const float* bias; PanelStats st1, st2; unsigned poison;
    __device__ __forceinline__ void fused(f32x4 (&acc)[2][2][4][2], const Unit& u, int wr, int wc, int fr, int fq, PG8_LAS unsigned char* lds, int wid, int lane) const {
        typedef float f32x2v __attribute__((ext_vector_type(2))); typedef unsigned u32x2v __attribute__((ext_vector_type(2)));
        const PG8_LAS f32x2v* S = (const PG8_LAS f32x2v*)(lds + 8192);
        const int col0 = u.pn * BM + wc * 32 + 4 * fq;
#pragma unroll
        for (int bj = 0; bj < 2; ++bj)
#pragma unroll
            for (int n = 0; n < 2; ++n) { const f32x4 bv = bias ? *(const f32x4*)(bias + col0 + bj * HALF + n * 16) : (f32x4){0.f, 0.f, 0.f, 0.f};
#pragma unroll
                for (int ai = 0; ai < 2; ++ai)
#pragma unroll
                    for (int m = 0; m < 4; ++m) acc[ai][bj][m][n] += bv; }
        bool bad = st1.run(acc, u, wr, wc, fr, fq, lds, wid, lane) || poison != 0u;
        const float qnan = __builtin_nanf("");
#pragma unroll
        for (int ai = 0; ai < 2; ++ai)
#pragma unroll
            for (int m = 0; m < 4; ++m) { const int r = ai * HALF + wr * 64 + m * 16 + fr; const f32x2v sr = S[r]; const size_t off = (size_t)(u.pm * BM + r) * ldc + col0;
#pragma unroll
                for (int bj = 0; bj < 2; ++bj)
#pragma unroll
                    for (int n = 0; n < 2; ++n) { const f32x4 bs = *(const f32x4*)(base + off + bj * HALF + n * 16); acc[ai][bj][m][n] = bs + (acc[ai][bj][m][n] - sr.x) * sr.y; }
                asm volatile("" : "+v"(acc[ai][0][m][0]), "+v"(acc[ai][0][m][1]), "+v"(acc[ai][1][m][0]), "+v"(acc[ai][1][m][1]));
                if (m & 1) asm volatile("" ::: "memory"); }
        const bool bad1 = bad;
        bad = st2.run(acc, u, wr, wc, fr, fq, lds, wid, lane) || bad;
#pragma unroll
        for (int ai = 0; ai < 2; ++ai)
#pragma unroll
            for (int m = 0; m < 4; ++m) { const int r = ai * HALF + wr * 64 + m * 16 + fr; const f32x2v sr = S[r]; const size_t off = (size_t)(u.pm * BM + r) * ldc + col0;
#pragma unroll
                for (int bj = 0; bj < 2; ++bj)
#pragma unroll
                    for (int n = 0; n < 2; ++n) { const f32x4 x1 = acc[ai][bj][m][n]; *(f32x4*)(out + off + bj * HALF + n * 16) = bad1 ? (f32x4){qnan, qnan, qnan, qnan} : x1;
                        const f32x4 o = (x1 - sr.x) * sr.y; u32x2v w; w.x = cvt_pk_bf16(o[0], o[1]); w.y = cvt_pk_bf16(o[2], o[3]);
                        if (bad) { w.x = 0x7fc07fc0u; w.y = 0x7fc07fc0u; } *(u32x2v*)(xn + off + bj * HALF + n * 16) = w; }
                asm volatile("" ::: "memory"); }
    }
};

template <class Epi, class Sched, bool ALIGN_EPI = false, bool SP2 = false>
__device__ __forceinline__ void gemm_phase(PG8_LAS unsigned char* lds, const Gemm g, const Sched& S, const Epi& E) {
    const int tid = threadIdx.x, wid = __builtin_amdgcn_readfirstlane(tid >> 6), lane = tid & 63, wr = wid >> 2, wc = wid & 3, fr = lane & 15, fq = lane >> 4;
    const int K = g.K, nt = K / BK;
    unsigned voffA[2], voffB[2];
#pragma unroll
    for (int i = 0; i < 2; ++i) { int R, C; stage_rc(tid * 16 + i * 8192, R, C); const int Rb = Epi::PERM ? ((R & ~31) + perm32(R & 31)) : R;
        voffA[i] = (unsigned)(R * g.lda + C) * 2u; voffB[i] = (unsigned)(Rb * K + C) * 2u; }
    const size_t kstep = (size_t)(BK * 2);
    const size_t hstepB = (size_t)HALF * K * 2, hstepA = (size_t)HALF * g.lda * 2;
    const size_t tstepB = 2 * hstepB, tstepA = 2 * hstepA;
    const unsigned ldsw = (unsigned)wid * 1024u;
    const int aoff = lds_byte(wr * 64 + fr, fq * 8), boff = lds_byte(wc * 32 + fr, fq * 8);
#define PG8_SA(b, h) (((b) * 2 + (h)) * HTB)
#define PG8_SB(b, h) ((4 + (b) * 2 + (h)) * HTB)
#define PG8_STAGE(bufoff, gbase, voff) do { _Pragma("unroll") for (int _i = 0; _i < 2; ++_i) \
        __builtin_amdgcn_global_load_lds((const unsigned*)((const char*)(gbase) + (voff)[_i]), (PG8_LAS unsigned*)(lds + (bufoff) + ldsw + _i * 8192), 16, 0, 0); } while (0)
#define PG8_LDA(dst, b, h) do { _Pragma("unroll") for (int m = 0; m < 4; ++m) _Pragma("unroll") for (int k = 0; k < 2; ++k) dst[m][k] = *(const PG8_LAS bf16x8*)(lds + PG8_SA(b, h) + aoff + m * 2048 + k * 1024); } while (0)
#define PG8_LDB(dst, b, h) do { _Pragma("unroll") for (int n = 0; n < 2; ++n) _Pragma("unroll") for (int k = 0; k < 2; ++k) dst[n][k] = *(const PG8_LAS bf16x8*)(lds + PG8_SB(b, h) + boff + n * 2048 + k * 1024); } while (0)
#define PG8_MMA(ai, bj, At, Bt) do { __builtin_amdgcn_s_setprio(1); _Pragma("unroll") for (int m = 0; m < 4; ++m) _Pragma("unroll") for (int n = 0; n < 2; ++n) _Pragma("unroll") for (int k = 0; k < 2; ++k) \
        acc[ai][bj][m][n] = __builtin_amdgcn_mfma_f32_16x16x32_bf16(Bt[n][k], At[m][k], acc[ai][bj][m][n], 0, 0, 0); __builtin_amdgcn_s_setprio(0); } while (0)
#define PG8_WAIT_V(n) asm volatile("s_waitcnt vmcnt(" #n ")" ::: "memory")
#define PG8_WAIT_L(n) asm volatile("s_waitcnt lgkmcnt(" #n ")" ::: "memory")
#define PG8_BAR __builtin_amdgcn_s_barrier()
#define PG8_SCHED __builtin_amdgcn_sched_barrier(0)
    Unit cur, nxt; int ui = 0;
    if (!S.next(0, cur)) return;
    f32x4 acc[2][2][4][2];
#pragma unroll
    for (int a = 0; a < 2; ++a)
#pragma unroll
        for (int b = 0; b < 2; ++b)
#pragma unroll
            for (int m = 0; m < 4; ++m)
#pragma unroll
                for (int n = 0; n < 2; ++n) acc[a][b][m][n] = (f32x4){0.f, 0.f, 0.f, 0.f};
    bf16x8 At[4][2], B0[2][2], B1[2][2];
    const char* cA = (const char*)g.A + (size_t)cur.pm * tstepA; const char* cB = (const char*)g.Bt + (size_t)cur.pn * tstepB;
    S.a_ready(cur);
    if constexpr (SP2) {
        PG8_STAGE(PG8_SB(0, 0), cB, voffB); PG8_STAGE(PG8_SB(0, 1), cB + hstepB, voffB); PG8_STAGE(PG8_SA(0, 0), cA, voffA); PG8_STAGE(PG8_SA(0, 1), cA + hstepA, voffA);
        if (wr == 1) PG8_BAR;
        PG8_WAIT_V(2); PG8_BAR;
        PG8_STAGE(PG8_SB(1, 0), cB + kstep, voffB); PG8_STAGE(PG8_SA(1, 0), cA + kstep, voffA); PG8_STAGE(PG8_SB(1, 1), cB + hstepB + kstep, voffB);
        PG8_WAIT_V(6); PG8_BAR;
    } else {
        PG8_STAGE(PG8_SB(0, 0), cB, voffB); PG8_STAGE(PG8_SA(0, 0), cA, voffA); PG8_STAGE(PG8_SB(0, 1), cB + hstepB, voffB); PG8_STAGE(PG8_SA(0, 1), cA + hstepA, voffA);
        if (wr == 1) PG8_BAR;
        PG8_WAIT_V(4); PG8_BAR;
        PG8_STAGE(PG8_SB(1, 0), cB + kstep, voffB); PG8_STAGE(PG8_SA(1, 0), cA + kstep, voffA); PG8_STAGE(PG8_SB(1, 1), cB + hstepB + kstep, voffB);
        PG8_WAIT_V(6); PG8_BAR;
    }
    for (;;) {
        const bool has_next = S.next(ui + 1, nxt);
        const char* nA = has_next ? (const char*)g.A + (size_t)nxt.pm * tstepA : cA; const char* nB = has_next ? (const char*)g.Bt + (size_t)nxt.pn * tstepB : cB;
        for (int t = 0; t < nt; t += 2) {
            const bool last = (t == nt - 2);
            const char* a1 = cA + (size_t)(t + 1) * kstep;
            const char* a2 = last ? nA : cA + (size_t)(t + 2) * kstep; const char* b2 = last ? nB : cB + (size_t)(t + 2) * kstep;
            const char* a3 = a2 + kstep; const char* b3 = b2 + kstep;
            if (last && has_next) S.a_ready(nxt);
            if constexpr (SP2) {
            PG8_LDB(B0, 0, 0); PG8_LDB(B1, 0, 1); PG8_SCHED; PG8_LDA(At, 0, 0); PG8_STAGE(PG8_SA(1, 1), a1 + hstepA, voffA);
            PG8_WAIT_V(8); PG8_WAIT_L(0); PG8_BAR; PG8_MMA(0, 0, At, B0); PG8_MMA(0, 1, At, B1); PG8_BAR; PG8_SCHED;
            PG8_LDA(At, 0, 1); PG8_STAGE(PG8_SB(0, 0), b2, voffB); PG8_STAGE(PG8_SB(0, 1), b2 + hstepB, voffB); PG8_STAGE(PG8_SA(0, 0), a2, voffA);
            PG8_WAIT_V(8); PG8_WAIT_L(0); PG8_BAR; PG8_MMA(1, 0, At, B0); PG8_MMA(1, 1, At, B1); PG8_BAR; PG8_SCHED;
            PG8_LDB(B0, 1, 0); PG8_LDB(B1, 1, 1); PG8_SCHED; PG8_LDA(At, 1, 0); PG8_STAGE(PG8_SA(0, 1), a2 + hstepA, voffA);
            PG8_WAIT_V(8); PG8_WAIT_L(0); PG8_BAR; PG8_MMA(0, 0, At, B0); PG8_MMA(0, 1, At, B1); PG8_BAR; PG8_SCHED;
            PG8_LDA(At, 1, 1); PG8_STAGE(PG8_SB(1, 0), b3, voffB); PG8_STAGE(PG8_SB(1, 1), b3 + hstepB, voffB); PG8_STAGE(PG8_SA(1, 0), a3, voffA);
            PG8_WAIT_V(8); PG8_WAIT_L(0); PG8_BAR; PG8_MMA(1, 0, At, B0); PG8_MMA(1, 1, At, B1); PG8_BAR; PG8_SCHED;
            } else {
            PG8_LDB(B0, 0, 0); PG8_SCHED; PG8_LDA(At, 0, 0); PG8_STAGE(PG8_SA(1, 1), a1 + hstepA, voffA);
            PG8_WAIT_L(8); PG8_BAR; PG8_WAIT_L(0); PG8_MMA(0, 0, At, B0); PG8_BAR; PG8_SCHED;
            PG8_LDB(B1, 0, 1); PG8_STAGE(PG8_SB(0, 0), b2, voffB);
            PG8_BAR; PG8_WAIT_L(0); PG8_MMA(0, 1, At, B1); PG8_BAR;
            PG8_LDA(At, 0, 1); PG8_STAGE(PG8_SA(0, 0), a2, voffA);
            PG8_BAR; PG8_WAIT_L(0); PG8_MMA(1, 0, At, B0); PG8_BAR; PG8_SCHED;
            PG8_STAGE(PG8_SB(0, 1), b2 + hstepB, voffB);
            PG8_WAIT_V(6); PG8_BAR; PG8_MMA(1, 1, At, B1); PG8_BAR;
            PG8_LDB(B0, 1, 0); PG8_SCHED; PG8_LDA(At, 1, 0); PG8_STAGE(PG8_SA(0, 1), a2 + hstepA, voffA);
            PG8_WAIT_L(8); PG8_BAR; PG8_WAIT_L(0); PG8_MMA(0, 0, At, B0); PG8_BAR; PG8_SCHED;
            PG8_LDB(B1, 1, 1); PG8_STAGE(PG8_SB(1, 0), b3, voffB);
            PG8_BAR; PG8_WAIT_L(0); PG8_MMA(0, 1, At, B1); PG8_BAR;
            PG8_LDA(At, 1, 1); PG8_STAGE(PG8_SA(1, 0), a3, voffA);
            PG8_BAR; PG8_WAIT_L(0); PG8_MMA(1, 0, At, B0); PG8_BAR; PG8_SCHED;
            PG8_STAGE(PG8_SB(1, 1), b3 + hstepB, voffB);
            PG8_WAIT_V(6); PG8_BAR; PG8_MMA(1, 1, At, B1); PG8_BAR;
            }
        }
        if constexpr (ALIGN_EPI) { if (wr == 0) PG8_BAR; }
        if constexpr (!Epi::AFTER_DRAIN) { E(acc, cur, wr, wc, fr, fq); S.done(cur); }
        if (!has_next) break;
#pragma unroll
        for (int a = 0; a < 2; ++a)
#pragma unroll
            for (int b = 0; b < 2; ++b)
#pragma unroll
                for (int m = 0; m < 4; ++m)
#pragma unroll
                    for (int n = 0; n < 2; ++n) acc[a][b][m][n] = (f32x4){0.f, 0.f, 0.f, 0.f};
        cur = nxt; cA = nA; cB = nB; ++ui;
        if constexpr (ALIGN_EPI) { if (wr == 1) PG8_BAR; }
    }
    PG8_WAIT_V(0);
    if constexpr (!ALIGN_EPI) { if (wr == 0) PG8_BAR; }
    PG8_BAR;
    if constexpr (Epi::AFTER_DRAIN) { E.fused(acc, cur, wr, wc, fr, fq, lds, wid, lane); S.done(cur); }
#undef PG8_SA
#undef PG8_SB
#undef PG8_STAGE
#undef PG8_LDA
#undef PG8_LDB
#undef PG8_MMA
#undef PG8_WAIT_V
#undef PG8_WAIT_L
#undef PG8_BAR
#undef PG8_SCHED
}
}
#define GAS __attribute__((address_space(1)))
#define LAS __attribute__((address_space(3)))
typedef unsigned short bf16;
typedef unsigned v4u __attribute__((ext_vector_type(4)));
typedef float f32x4 __attribute__((ext_vector_type(4)));
typedef short bf16x8 __attribute__((ext_vector_type(8)));
typedef GAS unsigned gu32;
typedef GAS unsigned long long gu64;
#define RLX_AGENT __ATOMIC_RELAXED, __HIP_MEMORY_SCOPE_AGENT
#define LDS_WAIT() asm volatile("s_waitcnt lgkmcnt(0)" ::: "memory")
#define VM_WAIT() asm volatile("s_waitcnt vmcnt(0)" ::: "memory")
__device__ __forceinline__ unsigned long long rt() { return __builtin_amdgcn_s_memrealtime(); }
__device__ __forceinline__ unsigned f2bf(float f) { unsigned u = __builtin_bit_cast(unsigned, f); return (u + 0x7fffu + ((u >> 16) & 1u)) >> 16; }
__device__ __forceinline__ unsigned pk2(float lo, float hi) { return f2bf(lo) | (f2bf(hi) << 16); }

#define XB_TMO      128
#define XB_XCNT(j)  (256  + 64 * (j))
#define XB_XSUB(j)  (1280 + 64 * (j))
#define XB_XGEN(j)  (2304 + 64 * (j))
#define XB_TOP      3328
#define XB_TOPGEN   3392
#define XCD_BAR_WORDS 3456
#define XB_SPIN_CAP (1u << 18)

__device__ __forceinline__ unsigned xb_ld(unsigned* p)              { return __hip_atomic_load(p, __ATOMIC_RELAXED, __HIP_MEMORY_SCOPE_AGENT); }
__device__ __forceinline__ unsigned xb_add(unsigned* p, unsigned v) { return __hip_atomic_fetch_add(p, v, __ATOMIC_RELAXED, __HIP_MEMORY_SCOPE_AGENT); }
__device__ __forceinline__ unsigned xb_xcc_id() { return (unsigned)__builtin_amdgcn_s_getreg((3 << 11) | 20) & 0xFu; }
#define XB_SPIN(cond, bar) do { unsigned _sp = 0; while (cond) { __builtin_amdgcn_s_sleep(1); \
    if ((++_sp & 255u) == 0u) { if (xb_ld(&(bar)[XB_TMO])) break; if (_sp > XB_SPIN_CAP) { atomicAdd(&(bar)[XB_TMO], 1u); break; } } } } while (0)

struct XcdBarrier {
    unsigned* bar; unsigned x;
    volatile LAS unsigned* st;
};

__device__ __forceinline__ XcdBarrier xcd_barrier_post(unsigned* bar, volatile LAS unsigned* st) {
    XcdBarrier b; b.bar = bar; b.x = xb_xcc_id(); b.st = st;
    if (threadIdx.x == 0) (void)xb_add(&bar[XB_XCNT(b.x)], 1u);
    return b;
}
__device__ __forceinline__ void xcd_barrier_complete(unsigned* bar, unsigned x, unsigned& nloc, unsigned& nx) {
    const unsigned G = gridDim.x * gridDim.y * gridDim.z;
    unsigned sum, cnt, mine, sp = 0u;
    for (;;) {
        sum = 0u; cnt = 0u; mine = 0u;
#pragma unroll
        for (unsigned j = 0; j < 16; ++j) { const unsigned c = xb_ld(&bar[XB_XCNT(j)]); sum += c; cnt += (c > 0u) ? 1u : 0u; mine = (j == x) ? c : mine; }
        if (sum == G) break;
        __builtin_amdgcn_s_sleep(1);
        if ((++sp & 255u) == 0u) { if (xb_ld(&bar[XB_TMO])) break; if (sp > XB_SPIN_CAP) { atomicAdd(&bar[XB_TMO], 1u); break; } }
    }
    nloc = mine > 0u ? mine : 1u; nx = cnt > 0u ? cnt : 1u;
}

__device__ __forceinline__ void xcd_barrier(const XcdBarrier& b) {
    asm volatile("s_waitcnt vmcnt(0)" ::: "memory");
    __syncthreads();
    if (threadIdx.x == 0) {
        unsigned* bar = b.bar;
        __builtin_amdgcn_s_waitcnt(0);
        unsigned nloc = b.st[0], nx = b.st[1];
        if (nloc == 0u) { xcd_barrier_complete(bar, b.x, nloc, nx); b.st[0] = nloc; b.st[1] = nx; }
        const unsigned old = xb_add(&bar[XB_XSUB(b.x)], 1u);
        const unsigned gen = old / nloc;
        if (old + 1u == (gen + 1u) * nloc) {
            __builtin_amdgcn_fence(__ATOMIC_RELEASE, "agent");
            asm volatile("s_waitcnt vmcnt(0)" ::: "memory");
            const unsigned og = xb_add(&bar[XB_TOP], 1u);
            const unsigned tg = og / nx;
            if (og + 1u == (tg + 1u) * nx) xb_add(&bar[XB_TOPGEN], 1u);
            else XB_SPIN(xb_ld(&bar[XB_TOPGEN]) == tg, bar);
            __builtin_amdgcn_fence(__ATOMIC_ACQUIRE, "agent");
            xb_add(&bar[XB_XGEN(b.x)], 1u);
            asm volatile("s_waitcnt vmcnt(0)" ::: "memory");
        } else {
            XB_SPIN(xb_ld(&bar[XB_XGEN(b.x)]) == gen, bar);
            __builtin_amdgcn_fence(__ATOMIC_ACQUIRE, "agent");
            asm volatile("s_waitcnt vmcnt(0)" ::: "memory");
        }
    }
    __syncthreads();
}
#ifdef ASMPK
#define EPK pg8::cvt_pk_bf16
#else
#define EPK pk2
#endif
typedef unsigned v2u __attribute__((ext_vector_type(2)));
typedef float f32x16 __attribute__((ext_vector_type(16)));
typedef short s16x4 __attribute__((ext_vector_type(4)));
__device__ __forceinline__ float bflo(unsigned u) { return __builtin_bit_cast(float, u << 16); }
__device__ __forceinline__ float bfhi(unsigned u) { return __builtin_bit_cast(float, u & 0xffff0000u); }
__device__ __forceinline__ float wave_sum(float v) {
#pragma unroll
    for (int o = 1; o < 64; o <<= 1) v += __shfl_xor(v, o);
    return v;
}

constexpr int NTOK = 16384, SEQ = 8192, DM = 4096, NIN = 10816, NINP = 11008, DFF = 16384, PLE = 256, NWAVES = 8;
constexpr int C_AQ = 0, C_AK = 1024, C_AV = 2048, C_BQ = 3072, C_BK = 4096, C_BV = 5120, C_CQ = 6144, C_CKV = 7168, C_CKR = 7680, C_DQ = 7744, C_DK = 8768, C_DV = 9792;
constexpr float LN_EPS = 1e-5f, RMS_EPS = 1e-6f, DN_ALPHA = 1.41421356237f;
constexpr size_t MiB = 1u << 20;
constexpr size_t WS_CTL = 0, CTL_ZERO_BYTES = 1 * MiB;
constexpr size_t WS_COS128 = 2 * MiB, WS_SIN128 = 4 * MiB, WS_COS64 = 6 * MiB, WS_SIN64 = 7 * MiB;
constexpr size_t WS_RSQ = 8 * MiB, WS_RSKV = 8 * MiB + 65536, WS_LSE = 9 * MiB;
constexpr size_t WS_WIN = 16 * MiB, WS_WO = 102 * MiB, WS_FF1 = 134 * MiB, WS_FF2 = 262 * MiB, WS_GATE = 390 * MiB, WS_PROJ = 422 * MiB, WS_UQ = 424 * MiB, WS_UKV = 427 * MiB;
constexpr size_t WS_XB = 430 * MiB, WS_H = 558 * MiB, WS_DP = 902 * MiB, WS_DO = 998 * MiB, WS_MIX = 1070 * MiB, WS_QM = 1198 * MiB, WS_KVM = 1246 * MiB, WS_Y = 1310 * MiB, WS_PB = 1566 * MiB, WS_END = 1574 * MiB;
constexpr int CW_BAR = 4096, CW_Q = 8192;
constexpr int RING_BYTES = 131072, MISC_OFF = RING_BYTES + 320, LDS_BYTES = 147456;

struct Args { const float* in[20]; float* out; unsigned char* ws; int L, pad; };

template <int ACT  > struct EpiB {
    static constexpr bool PERM = true, AFTER_DRAIN = false;
    bf16* O; int ldc; const float* rowscale;
    __device__ __forceinline__ void operator()(const pg8::f32x4 (&acc)[2][2][4][2], const pg8::Unit& u, int wr, int wc, int fr, int fq) const {
        const int row0 = u.pm * 256 + wr * 64 + fr, col0 = u.pn * 256 + wc * 32 + 8 * fq;
#pragma unroll
        for (int ai = 0; ai < 2; ++ai)
#pragma unroll
            for (int m = 0; m < 4; ++m) { const int row = row0 + ai * 128 + m * 16; bf16* rowp = O + (size_t)row * ldc + col0;
                const float rs = rowscale ? rowscale[row] : 1.f;
#pragma unroll
                for (int bj = 0; bj < 2; ++bj) { pg8::f32x4 v0 = acc[ai][bj][m][0], v1 = acc[ai][bj][m][1];
                    if (ACT == 2) {
#pragma unroll
                        for (int e = 0; e < 4; ++e) { float a = v0[e] > 0.f ? v0[e] : 0.f; v0[e] = a * a; float b = v1[e] > 0.f ? v1[e] : 0.f; v1[e] = b * b; } }
                    v0 = v0 * rs; v1 = v1 * rs;
                    v4u w; w.x = EPK(v0[0], v0[1]); w.y = EPK(v0[2], v0[3]); w.z = EPK(v1[0], v1[1]); w.w = EPK(v1[2], v1[3]);
                    *(v4u*)(rowp + bj * 128) = w; } }
    }
};
template <int GATE  > struct EpiF {
    static constexpr bool PERM = true, AFTER_DRAIN = false;
    float* O; const float* G; int ldc;
    __device__ __forceinline__ void operator()(const pg8::f32x4 (&acc)[2][2][4][2], const pg8::Unit& u, int wr, int wc, int fr, int fq) const {
        const int row0 = u.pm * 256 + wr * 64 + fr, col0 = u.pn * 256 + wc * 32 + 8 * fq;
#pragma unroll
        for (int ai = 0; ai < 2; ++ai)
#pragma unroll
            for (int m = 0; m < 4; ++m) { const size_t off = (size_t)(row0 + ai * 128 + m * 16) * ldc + col0;
#pragma unroll
                for (int bj = 0; bj < 2; ++bj) { pg8::f32x4 v0 = acc[ai][bj][m][0], v1 = acc[ai][bj][m][1];
                    if (GATE) { const pg8::f32x4 g0 = *(const pg8::f32x4*)(G + off + bj * 128), g1 = *(const pg8::f32x4*)(G + off + bj * 128 + 4);
#pragma unroll
                        for (int e = 0; e < 4; ++e) { v0[e] = g0[e] / (1.f + __expf(-v0[e])); v1[e] = g1[e] / (1.f + __expf(-v1[e])); } }
                    *(pg8::f32x4*)(O + off + bj * 128) = v0; *(pg8::f32x4*)(O + off + bj * 128 + 4) = v1; } }
    }
};

__device__ __forceinline__ void transpose_item(const float* W, int K, int N, bf16* WT, const float* ks, LAS float* scr, int item, int lane) {
    const int nblk = N / 32, kb = item / nblk, nb = item % nblk, k0 = 64 * kb, n0 = 32 * nb;
#pragma unroll 8
    for (int i = 0; i < 32; ++i) { const int kk = 2 * i + (lane >> 5); float v = W[(size_t)(k0 + kk) * N + n0 + (lane & 31)]; if (ks) v *= ks[k0 + kk]; scr[kk * 33 + (lane & 31)] = v; }
    LDS_WAIT(); asm volatile("" ::: "memory");
    const int c = lane & 7;
#pragma unroll
    for (int j = 0; j < 4; ++j) { const int n = (lane >> 3) + 8 * j; const LAS float* s = scr + (8 * c) * 33 + n;
        v4u o; o.x = pk2(s[0 * 33], s[1 * 33]); o.y = pk2(s[2 * 33], s[3 * 33]); o.z = pk2(s[4 * 33], s[5 * 33]); o.w = pk2(s[6 * 33], s[7 * 33]);
        *(v4u*)(WT + (size_t)(n0 + n) * K + k0 + 8 * c) = o; }
    LDS_WAIT(); asm volatile("" ::: "memory");
}
__device__ __forceinline__ void cvt_rows(const float* src, bf16* dst, size_t n8, size_t gtid, size_t gthreads) {
    for (size_t i = gtid; i < n8; i += gthreads) { const f32x4 a = *(const f32x4*)(src + i * 8), b = *(const f32x4*)(src + i * 8 + 4);
        v4u w; w.x = pk2(a[0], a[1]); w.y = pk2(a[2], a[3]); w.z = pk2(b[0], b[1]); w.w = pk2(b[2], b[3]); *(v4u*)(dst + i * 8) = w; }
}

__device__ __forceinline__ void ln_rows(const float* xs, const float* y, const float* g, const float* b, float* xo, bf16* xb, int gw, int ngw, int lane) {
    for (int r = gw; r < NTOK; r += ngw) {
        const f32x4* xr = (const f32x4*)(xs + (size_t)r * DM) + lane; const f32x4* yr = (const f32x4*)(y + (size_t)r * DM) + lane;
        f32x4 v[16]; float s = 0.f;
#pragma unroll
        for (int j = 0; j < 16; ++j) { const f32x4 a = xr[64 * j], c = yr[64 * j]; v[j] = a * DN_ALPHA + c; s += (v[j][0] + v[j][1]) + (v[j][2] + v[j][3]); }
        const float mean = wave_sum(s) * (1.f / DM); float s2 = 0.f;
#pragma unroll
        for (int j = 0; j < 16; ++j) { v[j] = v[j] - mean; s2 += (v[j][0] * v[j][0] + v[j][1] * v[j][1]) + (v[j][2] * v[j][2] + v[j][3] * v[j][3]); }
        const float rstd = 1.f / sqrtf(wave_sum(s2) * (1.f / DM) + LN_EPS);
        f32x4* orow = (f32x4*)(xo + (size_t)r * DM) + lane; v2u* brow = (v2u*)(xb + (size_t)r * DM) + lane;
#pragma unroll
        for (int j = 0; j < 16; ++j) { const f32x4 gg = ((const f32x4*)g)[lane + 64 * j], bb = ((const f32x4*)b)[lane + 64 * j]; const f32x4 o = v[j] * rstd * gg + bb;
            orow[64 * j] = o; v2u w; w.x = pk2(o[0], o[1]); w.y = pk2(o[2], o[3]); brow[64 * j] = w; }
    }
}

__device__ __forceinline__ void rope8(bf16* p1, bf16* p2, const float* cs, const float* sn) {
    const v4u a = *(const v4u*)p1, b = *(const v4u*)p2; const f32x4 c0 = *(const f32x4*)cs, c1 = *(const f32x4*)(cs + 4), s0 = *(const f32x4*)sn, s1 = *(const f32x4*)(sn + 4);
    float x1[8], x2[8], c[8], s[8];
#pragma unroll
    for (int e = 0; e < 4; ++e) { x1[2 * e] = bflo(a[e]); x1[2 * e + 1] = bfhi(a[e]); x2[2 * e] = bflo(b[e]); x2[2 * e + 1] = bfhi(b[e]); c[e] = c0[e]; c[e + 4] = c1[e]; s[e] = s0[e]; s[e + 4] = s1[e]; }
    v4u oa, ob;
#pragma unroll
    for (int e = 0; e < 4; ++e) {
        const float y1a = x1[2 * e] * c[2 * e] - x2[2 * e] * s[2 * e], y1b = x1[2 * e + 1] * c[2 * e + 1] - x2[2 * e + 1] * s[2 * e + 1];
        const float y2a = x2[2 * e] * c[2 * e] + x1[2 * e] * s[2 * e], y2b = x2[2 * e + 1] * c[2 * e + 1] + x1[2 * e + 1] * s[2 * e + 1];
        oa[e] = pk2(y1a, y1b); ob[e] = pk2(y2a, y2b); }
    *(v4u*)p1 = oa; *(v4u*)p2 = ob;
}
__device__ __forceinline__ float sumsq8(const bf16* p) { const v4u a = *(const v4u*)p; float s = 0.f;
#pragma unroll
    for (int e = 0; e < 4; ++e) { const float lo = bflo(a[e]), hi = bfhi(a[e]); s += lo * lo + hi * hi; } return s; }
__device__ __forceinline__ void rope_rows(bf16* H, const float* cos128, const float* sin128, const float* cos64, const float* sin64, float* rsq, float* rskv, int gw, int ngw, int lane) {
    for (int r = gw; r < NTOK; r += ngw) {
        bf16* hr = H + (size_t)r * NINP; const int pos = r % SEQ;
        const int j0 = 8 * (lane & 7), hd = lane >> 3;
#pragma unroll
        for (int it = 0; it < 4; ++it) {
            const int head = hd + 8 * it; bf16* base = hr + (head < 16 ? C_BQ + head * 128 : C_DQ + (head - 16) * 128) + j0;
            rope8(base, base + 64, cos128 + (size_t)pos * 64 + j0, sin128 + (size_t)pos * 64 + j0); }
        if (lane < 4) rope8(hr + C_CKR + 8 * lane, hr + C_CKR + 32 + 8 * lane, cos64 + (size_t)pos * 32 + 8 * lane, sin64 + (size_t)pos * 32 + 8 * lane);
        float sq = sumsq8(hr + C_CQ + 8 * lane) + sumsq8(hr + C_CQ + 512 + 8 * lane); float skv = sumsq8(hr + C_CKV + 8 * lane);
        sq = wave_sum(sq); skv = wave_sum(skv);
        if (lane == 0) { rsq[r] = 1.f / sqrtf(sq * (1.f / 1024.f) + RMS_EPS); rskv[r] = 1.f / sqrtf(skv * (1.f / 512.f) + RMS_EPS); }
    }
}

__device__ __forceinline__ void combine_rows(const bf16* DP, const float* LSE, const bf16* DO, const float* lamp, const float* subln, float lam_init, bf16* MIX, int gw, int ngw, int lane) {
    float d0 = lamp[lane] * lamp[128 + lane] + lamp[64 + lane] * lamp[192 + lane], d1 = lamp[256 + lane] * lamp[384 + lane] + lamp[320 + lane] * lamp[448 + lane];
    d0 = wave_sum(d0); d1 = wave_sum(d1);
    const float lam = __expf(d0) - __expf(d1) + lam_init, post = 1.f - lam_init;
    for (int r = gw; r < NTOK; r += ngw) {
#pragma unroll
        for (int i = 0; i < 2; ++i) {
            const int col = 8 * (lane + 64 * i), hd = col >> 7;
            const float l0 = LSE[(size_t)r * 8 + hd], l1 = LSE[(size_t)(NTOK + r) * 8 + hd], l2 = LSE[(size_t)(2 * NTOK + r) * 8 + hd];
            const float mx = fmaxf(l0, fmaxf(l1, l2)); float w0 = __expf(l0 - mx), w1 = __expf(l1 - mx), w2 = __expf(l2 - mx); const float inv = 1.f / (w0 + w1 + w2); w0 *= inv; w1 *= inv; w2 *= inv;
            const v4u a = *(const v4u*)(DP + (size_t)r * 1024 + col), b = *(const v4u*)(DP + ((size_t)NTOK + r) * 1024 + col), c = *(const v4u*)(DP + ((size_t)2 * NTOK + r) * 1024 + col);
            v4u o;
#pragma unroll
            for (int e = 0; e < 4; ++e) o[e] = pk2(w0 * bflo(a[e]) + w1 * bflo(b[e]) + w2 * bflo(c[e]), w0 * bfhi(a[e]) + w1 * bfhi(b[e]) + w2 * bfhi(c[e]));
            *(v4u*)(MIX + (size_t)r * DM + 1024 + col) = o; }
#pragma unroll
        for (int i = 0; i < 2; ++i) {
            const int col = 8 * (lane + 64 * i), dcol = col & 255;
            const v4u a = *(const v4u*)(DO + (size_t)r * 1024 + col), b = *(const v4u*)(DO + ((size_t)NTOK + r) * 1024 + col);
            float v[8]; float ss = 0.f;
#pragma unroll
            for (int e = 0; e < 4; ++e) { v[2 * e] = bflo(a[e]) - lam * bflo(b[e]); v[2 * e + 1] = bfhi(a[e]) - lam * bfhi(b[e]); ss += v[2 * e] * v[2 * e] + v[2 * e + 1] * v[2 * e + 1]; }
#pragma unroll
            for (int o = 1; o < 32; o <<= 1) ss += __shfl_xor(ss, o);
            const float rs = post / sqrtf(ss * (1.f / 256.f) + RMS_EPS);
            const f32x4 g0 = *(const f32x4*)(subln + dcol), g1 = *(const f32x4*)(subln + dcol + 4);
            v4u o; o.x = pk2(v[0] * rs * g0[0], v[1] * rs * g0[1]); o.y = pk2(v[2] * rs * g0[2], v[3] * rs * g0[3]); o.z = pk2(v[4] * rs * g1[0], v[5] * rs * g1[1]); o.w = pk2(v[6] * rs * g1[2], v[7] * rs * g1[3]);
            *(v4u*)(MIX + (size_t)r * DM + 3072 + col) = o; }
    }
}
struct AttnDesc {
    const bf16* Q; const bf16* K; const bf16* K2; const bf16* V; bf16* O; float* LSE; const float* cosT; const float* sinT;
    int ldq, ldk, ldk2, ldv, ldo, lse_ld;
    int row0, rstride, iq0, W, pos0; float scale;
};
#define MFMA32(a, b, c) __builtin_amdgcn_mfma_f32_32x32x16_bf16((a), (b), (c), 0, 0, 0)
__device__ __forceinline__ bf16x8 pack8(const f32x16& x, int s) {
    v4u p; p.x = pk2(x[8 * s], x[8 * s + 1]); p.y = pk2(x[8 * s + 2], x[8 * s + 3]); p.z = pk2(x[8 * s + 4], x[8 * s + 5]); p.w = pk2(x[8 * s + 6], x[8 * s + 7]);
    return __builtin_bit_cast(bf16x8, p);
}
constexpr float LOG2E = 1.44269504089f, LN2 = 0.69314718056f;

template <int DK, int MODE  , bool ROPEQ>
__device__ __forceinline__ void attn_unit(LAS unsigned char* lds, const AttnDesc& d, int tid, int wid, int lane) {
    constexpr int NKC = DK / 16, KS = DK * 2 + 16, VS = 136, NKP = DK / 64, KCH = DK / 8;
    LAS unsigned char* ldsK = lds; LAS unsigned char* ldsV = lds + 64 * KS;
    const int n = lane & 31, h = lane >> 5;
    const int iq = d.iq0 + 32 * wid + n;
    const size_t qtok = (size_t)d.row0 + (size_t)iq * d.rstride;
    bf16x8 qf[NKC];
    { const bf16* qrow = d.Q + qtok * d.ldq;
#pragma unroll
      for (int c = 0; c < NKC; ++c) qf[c] = *(const bf16x8*)(qrow + 16 * c + 8 * h); }
    if constexpr (ROPEQ) {
        const int pos = d.pos0 + iq * d.rstride;
#pragma unroll
        for (int cc = 0; cc < 2; ++cc) { const int j0 = 16 * cc + 8 * h; const float* cp = d.cosT + (size_t)pos * 32 + j0; const float* sp = d.sinT + (size_t)pos * 32 + j0;
            const v4u a = __builtin_bit_cast(v4u, qf[8 + cc]), b = __builtin_bit_cast(v4u, qf[10 + cc]); v4u oa, ob;
#pragma unroll
            for (int e = 0; e < 4; ++e) { const float c0 = cp[2 * e], c1 = cp[2 * e + 1], s0 = sp[2 * e], s1 = sp[2 * e + 1];
                const float x1a = bflo(a[e]), x1b = bfhi(a[e]), x2a = bflo(b[e]), x2b = bfhi(b[e]);
                oa[e] = pk2(x1a * c0 - x2a * s0, x1b * c1 - x2b * s1); ob[e] = pk2(x2a * c0 + x1a * s0, x2b * c1 + x1b * s1); }
            qf[8 + cc] = __builtin_bit_cast(bf16x8, oa); qf[10 + cc] = __builtin_bit_cast(bf16x8, ob); }
    }
    const int jhi = d.iq0 / 64 + 3; int lo_key = d.iq0 - d.W; if (lo_key < 0) lo_key = 0; const int jlo = lo_key / 64;
    const int wq_min = d.iq0 + 32 * wid, wq_max = wq_min + 31;
    f32x16 o[4];
#pragma unroll
    for (int s = 0; s < 4; ++s)
#pragma unroll
        for (int e = 0; e < 16; ++e) o[s][e] = 0.f;
    float m_run = -INFINITY, l_run = 0.f, carry = 0.f;
    const float sc2 = d.scale * LOG2E;
    v4u kreg[NKP], vreg[2];
    const int vkey = tid & 63, vch0 = tid >> 6;
#define ATT_PREFETCH(j) do { \
        _Pragma("unroll") for (int i = 0; i < NKP; ++i) { const int p = tid + 512 * i, key = p / KCH, ch = p % KCH; const size_t tok = (size_t)d.row0 + (size_t)(64 * (j) + key) * d.rstride; \
            const bf16* src = (DK == 192 && ch >= 16) ? d.K2 + tok * d.ldk2 + (ch - 16) * 8 : d.K + tok * d.ldk + ch * 8; kreg[i] = *(const v4u*)src; } \
        { const size_t tok = (size_t)d.row0 + (size_t)(64 * (j) + vkey) * d.rstride; const bf16* src = d.V + tok * d.ldv; \
          vreg[0] = *(const v4u*)(src + vch0 * 8); vreg[1] = *(const v4u*)(src + (vch0 + 8) * 8); } } while (0)
    for (int j = jhi; j >= jlo; --j) {
        __syncthreads();
        ATT_PREFETCH(j);
#pragma unroll
        for (int i = 0; i < NKP; ++i) { const int p = tid + 512 * i, key = p / KCH, ch = p % KCH; *(LAS v4u*)(ldsK + key * KS + ch * 16) = kreg[i]; }
#pragma unroll
        for (int i = 0; i < 2; ++i) { const int dv0 = (vch0 + 8 * i) * 8;
#pragma unroll
            for (int e = 0; e < 4; ++e) { *(LAS unsigned short*)(ldsV + (dv0 + 2 * e) * VS + vkey * 2) = (unsigned short)(vreg[i][e] & 0xffffu); *(LAS unsigned short*)(ldsV + (dv0 + 2 * e + 1) * VS + vkey * 2) = (unsigned short)(vreg[i][e] >> 16); } }
        __syncthreads();
        const int k0 = 64 * j;
        if (k0 > wq_max || (wq_min - (k0 + 63)) > d.W) continue;
        f32x16 s0, s1;
#pragma unroll
        for (int e = 0; e < 16; ++e) { s0[e] = 0.f; s1[e] = 0.f; }
#pragma unroll
        for (int c = 0; c < NKC; ++c) {
            const bf16x8 a0 = *(const LAS bf16x8*)(ldsK + n * KS + c * 32 + h * 16), a1 = *(const LAS bf16x8*)(ldsK + (32 + n) * KS + c * 32 + h * 16);
            s0 = MFMA32(a0, qf[c], s0); s1 = MFMA32(a1, qf[c], s1); }
        const bool full = (k0 + 63 <= wq_min - MODE) && (wq_max - k0 <= d.W);
        if constexpr (MODE == 0) {
#pragma unroll
            for (int e = 0; e < 16; ++e) { s0[e] *= sc2; s1[e] *= sc2; }
            if (!full) {
#pragma unroll
                for (int e = 0; e < 16; ++e) { const int ik = k0 + (e & 3) + 8 * (e >> 2) + 4 * h; const int dd0 = iq - ik, dd1 = dd0 - 32;
                    if (dd0 < 0 || dd0 > d.W) s0[e] = -INFINITY; if (dd1 < 0 || dd1 > d.W) s1[e] = -INFINITY; } }
            float mx = s0[0];
#pragma unroll
            for (int e = 1; e < 16; ++e) mx = fmaxf(mx, s0[e]);
#pragma unroll
            for (int e = 0; e < 16; ++e) mx = fmaxf(mx, s1[e]);
            mx = fmaxf(mx, __shfl_xor(mx, 32));
            const float m_new = fmaxf(m_run, mx);
            const float msafe = (m_new == -INFINITY) ? 0.f : m_new;
            const float alpha = __builtin_amdgcn_exp2f(m_run - msafe);
            float rs = 0.f;
#pragma unroll
            for (int e = 0; e < 16; ++e) { s0[e] = __builtin_amdgcn_exp2f(s0[e] - msafe); s1[e] = __builtin_amdgcn_exp2f(s1[e] - msafe); rs += s0[e] + s1[e]; }
            l_run = l_run * alpha + rs; m_run = m_new;
#pragma unroll
            for (int s = 0; s < 4; ++s)
#pragma unroll
                for (int e = 0; e < 16; ++e) o[s][e] *= alpha;
        } else {
            const float sc = d.scale;
#pragma unroll
            for (int t = 1; t >= 0; --t) {
                f32x16& S = t ? s1 : s0; float l1m[16]; float g[4], pg[4];
#pragma unroll
                for (int e = 0; e < 16; ++e) { const int ik = k0 + 32 * t + (e & 3) + 8 * (e >> 2) + 4 * h; const bool valid = full || (ik < iq);
                    const float z = S[e] * sc; const float lp = __builtin_amdgcn_logf(1.f + __builtin_amdgcn_exp2f(-fabsf(z) * LOG2E)) * LN2;
                    const float lb = fminf(z, 0.f) - lp;
                    l1m[e] = valid ? (lb - z) : 0.f;
                    S[e] = valid ? lb : -INFINITY; }
#pragma unroll
                for (int i = 0; i < 4; ++i) { g[i] = (l1m[4 * i] + l1m[4 * i + 1]) + (l1m[4 * i + 2] + l1m[4 * i + 3]); pg[i] = __shfl_xor(g[i], 32); }
                float run = carry;
#pragma unroll
                for (int i = 3; i >= 0; --i) { float acc = run + (h == 0 ? pg[i] : 0.f);
#pragma unroll
                    for (int jj = 3; jj >= 0; --jj) { const int e = 4 * i + jj; S[e] = __builtin_amdgcn_exp2f((S[e] + acc) * LOG2E); acc += l1m[e]; }
                    run += g[i] + pg[i]; }
                carry = run;
            }
        }
        bf16x8 pf[2][2];
        pf[0][0] = pack8(s0, 0); pf[0][1] = pack8(s0, 1); pf[1][0] = pack8(s1, 0); pf[1][1] = pack8(s1, 1);
#pragma unroll
        for (int s = 0; s < 4; ++s)
#pragma unroll
            for (int t = 0; t < 2; ++t)
#pragma unroll
                for (int c = 0; c < 2; ++c) { const LAS unsigned char* vp = ldsV + (32 * s + n) * VS + (32 * t + 16 * c + 4 * h) * 2;
                    const s16x4 v0 = *(const LAS s16x4*)vp, v1 = *(const LAS s16x4*)(vp + 16);
                    const bf16x8 vf = __builtin_shufflevector(v0, v1, 0, 1, 2, 3, 4, 5, 6, 7);
                    o[s] = MFMA32(vf, pf[t][c], o[s]); }
    }
#undef ATT_PREFETCH
    float inv = 1.f;
    if constexpr (MODE == 0) { const float l = l_run + __shfl_xor(l_run, 32); inv = 1.f / l;
        if (d.LSE && h == 0) d.LSE[qtok * d.lse_ld] = (m_run + __builtin_amdgcn_logf(l)) * LN2; }
    bf16* orow = d.O + qtok * d.ldo;
#pragma unroll
    for (int s = 0; s < 4; ++s)
#pragma unroll
        for (int i = 0; i < 4; ++i) { v2u w; w.x = pk2(o[s][4 * i] * inv, o[s][4 * i + 1] * inv); w.y = pk2(o[s][4 * i + 2] * inv, o[s][4 * i + 3] * inv);
            *(v2u*)(orow + 32 * s + 8 * i + 4 * h) = w; }
}

#define WSL unsigned char* wsl = args.ws; asm volatile("" : "+s"(wsl))
#define WP(T, off) ((T*)(wsl + (off)))
#define PH_ON(k) if constexpr (PH < 0 || PH == (k))
#define GRIDBAR() do { if constexpr (PH < 0) xcd_barrier(bar); } while (0)
#define ONE_LAUNCH 0
#if ONE_LAUNCH
__global__ void __launch_bounds__(512, 2) hybrid_one(Args args) {

    extern __shared__ __attribute__((aligned(16))) unsigned char lds_raw[];
    LAS unsigned char* lds = (LAS unsigned char*)lds_raw;
    volatile LAS unsigned* MISC = (volatile LAS unsigned*)(lds + MISC_OFF);
    const int tid = threadIdx.x, lane = tid & 63, wave = __builtin_amdgcn_readfirstlane(tid >> 6);
    const int G = gridDim.x, gw = blockIdx.x * NWAVES + wave, ngw = G * NWAVES;
    for (int u = tid; u < (LDS_BYTES - RING_BYTES) / 4; u += 512) ((LAS unsigned*)(lds + RING_BYTES))[u] = 0u;
    __syncthreads();

    XcdBarrier bar = xcd_barrier_post((unsigned*)((gu32*)(args.ws + WS_CTL) + CW_BAR), MISC + 8);
    { constexpr int L = 0; constexpr int PH = -1;

        PH_ON(0) {
            WSL; const size_t gtid = (size_t)blockIdx.x * 512 + tid, gthreads = (size_t)G * 512;
            LAS float* scr = (LAS float*)(lds + wave * 16384);
            constexpr int I_IN = 64 * (NIN / 32), I_O = 64 * 128, I_UQ = 16 * 48, I_UKV = 8 * 64, I_F1 = 64 * 512, I_F2 = 256 * 128, I_G = 64 * 128, I_P = 4 * 128;
            constexpr int NITEMS = I_IN + I_O + I_UQ + I_UKV + I_F1 + I_F2 + I_G + I_P;
            for (int it = gw; it < NITEMS; it += ngw) {
                int r = it;
                if (r < I_IN) { transpose_item(args.in[2] + (size_t)L * DM * NIN, DM, NIN, WP(bf16, WS_WIN), nullptr, scr, r, lane); continue; } r -= I_IN;
                if (r < I_O) { transpose_item(args.in[3] + (size_t)L * DM * DM, DM, DM, WP(bf16, WS_WO), nullptr, scr, r, lane); continue; } r -= I_O;
                if (r < I_UQ) { transpose_item(args.in[5] + (size_t)L * 1024 * 1536, 1024, 1536, WP(bf16, WS_UQ), args.in[4] + (size_t)L * 1024, scr, r, lane); continue; } r -= I_UQ;
                if (r < I_UKV) { transpose_item(args.in[7] + (size_t)L * 512 * 2048, 512, 2048, WP(bf16, WS_UKV), args.in[6] + (size_t)L * 512, scr, r, lane); continue; } r -= I_UKV;
                if (r < I_F1) { transpose_item(args.in[12] + (size_t)L * DM * DFF, DM, DFF, WP(bf16, WS_FF1), nullptr, scr, r, lane); continue; } r -= I_F1;
                if (r < I_F2) { transpose_item(args.in[13] + (size_t)L * DFF * DM, DFF, DM, WP(bf16, WS_FF2), nullptr, scr, r, lane); continue; } r -= I_F2;
                if (r < I_G) { transpose_item(args.in[16] + (size_t)L * DM * DM, DM, DM, WP(bf16, WS_GATE), nullptr, scr, r, lane); continue; } r -= I_G;
                transpose_item(args.in[17] + (size_t)L * PLE * DM, PLE, DM, WP(bf16, WS_PROJ), nullptr, scr, r, lane);
            }
            { v4u z = {0u, 0u, 0u, 0u}; v4u* pad = (v4u*)(WP(bf16, WS_WIN) + (size_t)NIN * DM); const size_t n16 = (size_t)(NINP - NIN) * DM / 8; for (size_t i = gtid; i < n16; i += gthreads) pad[i] = z; }
            cvt_rows(args.in[1] + (size_t)L * NTOK * PLE, WP(bf16, WS_PB), (size_t)NTOK * PLE / 8, gtid, gthreads);
            if (L == 0) {
                cvt_rows(args.in[0], WP(bf16, WS_XB), (size_t)NTOK * DM / 8, gtid, gthreads);
                float* cos128 = WP(float, WS_COS128); float* sin128 = WP(float, WS_SIN128); float* cos64 = WP(float, WS_COS64); float* sin64 = WP(float, WS_SIN64);
                for (size_t i = gtid; i < (size_t)SEQ * 64; i += gthreads) { const int pos = (int)(i >> 6), j = (int)(i & 63); const float inv = powf(10000.0f, -(float)j / 64.0f); const float ang = (float)pos * inv; cos128[i] = cosf(ang); sin128[i] = sinf(ang); }
                for (size_t i = gtid; i < (size_t)SEQ * 32; i += gthreads) { const int pos = (int)(i >> 5), j = (int)(i & 31); const float inv = powf(10000.0f, -(float)j / 32.0f); const float ang = (float)pos * inv; cos64[i] = cosf(ang); sin64[i] = sinf(ang); }
            }
        }
        GRIDBAR();
        PH_ON(1) { WSL; pg8::Gemm g{WP(bf16, WS_XB), WP(bf16, WS_WIN), NTOK, NINP, DM, DM}; pg8::StaticOrder S; S.init(NTOK, NINP, G, (int)blockIdx.x); EpiB<0> E{WP(bf16, WS_H), NINP, nullptr};
          pg8::gemm_phase<EpiB<0>, pg8::StaticOrder, true, true>(lds, g, S, E); }
        GRIDBAR();
        PH_ON(2) { WSL; rope_rows(WP(bf16, WS_H), WP(float, WS_COS128), WP(float, WS_SIN128), WP(float, WS_COS64), WP(float, WS_SIN64), WP(float, WS_RSQ), WP(float, WS_RSKV), gw, ngw, lane); }
        GRIDBAR();
        PH_ON(3) {
        { WSL; pg8::Gemm g{WP(bf16, WS_H) + C_CQ, WP(bf16, WS_UQ), NTOK, 1536, 1024, NINP}; pg8::StaticOrder S; S.init(NTOK, 1536, G, (int)blockIdx.x); EpiB<0> E{WP(bf16, WS_QM), 1536, WP(float, WS_RSQ)};
          pg8::gemm_phase<EpiB<0>, pg8::StaticOrder, true, true>(lds, g, S, E); }
        __syncthreads();
        { WSL; pg8::Gemm g{WP(bf16, WS_H) + C_CKV, WP(bf16, WS_UKV), NTOK, 2048, 512, NINP}; pg8::StaticOrder S; S.init(NTOK, 2048, G, (int)blockIdx.x); EpiB<0> E{WP(bf16, WS_KVM), 2048, WP(float, WS_RSKV)};
          pg8::gemm_phase<EpiB<0>, pg8::StaticOrder, true, true>(lds, g, S, E); }
        }
        GRIDBAR();
        PH_ON(4) {
            LAS unsigned* uq = (LAS unsigned*)(lds + MISC_OFF + 64);
            { WSL; gu32* ctl = WP(gu32, WS_CTL); bf16* H = WP(bf16, WS_H); bf16* MIX = WP(bf16, WS_MIX);
            for (;;) {
                __syncthreads(); if (tid == 0) *uq = __hip_atomic_fetch_add(ctl + CW_Q + 64 * (L * 4 + 0), 1u, RLX_AGENT); __syncthreads();
                const int u = (int)*uq; if (u >= 512) break;
                const int qb = 31 - u / 16, bh = u % 16, b = bh / 8, hd = bh % 8;
                AttnDesc d; d.Q = H + C_AQ + hd * 128; d.K = H + C_AK + hd * 128; d.K2 = nullptr; d.V = H + C_AV + hd * 128; d.O = MIX + hd * 128; d.LSE = nullptr; d.cosT = nullptr; d.sinT = nullptr;
                d.ldq = NINP; d.ldk = NINP; d.ldk2 = 0; d.ldv = NINP; d.ldo = DM; d.lse_ld = 0; d.row0 = b * SEQ; d.rstride = 1; d.iq0 = qb * 256; d.W = 1 << 29; d.pos0 = 0; d.scale = 0.08838834764831845f;
                attn_unit<128, 1, false>(lds, d, tid, wave, lane);
            } }
            { WSL; gu32* ctl = WP(gu32, WS_CTL); bf16* QM = WP(bf16, WS_QM); bf16* KVM = WP(bf16, WS_KVM);
            for (;;) {
                __syncthreads(); if (tid == 0) *uq = __hip_atomic_fetch_add(ctl + CW_Q + 64 * (L * 4 + 1), 1u, RLX_AGENT); __syncthreads();
                const int u = (int)*uq; if (u >= 512) break;
                const int qb = 31 - u / 16, bh = u % 16, b = bh / 8, hd = bh % 8;
                AttnDesc d; d.Q = QM + hd * 192; d.K = KVM + hd * 256; d.K2 = WP(bf16, WS_H) + C_CKR; d.V = KVM + hd * 256 + 128; d.O = WP(bf16, WS_MIX) + 2048 + hd * 128; d.LSE = nullptr; d.cosT = WP(float, WS_COS64); d.sinT = WP(float, WS_SIN64);
                d.ldq = 1536; d.ldk = 2048; d.ldk2 = NINP; d.ldv = 2048; d.ldo = DM; d.lse_ld = 0; d.row0 = b * SEQ; d.rstride = 1; d.iq0 = qb * 256; d.W = 1 << 29; d.pos0 = 0; d.scale = 0.07216878364870323f;
                attn_unit<192, 0, true>(lds, d, tid, wave, lane);
            } }
            { WSL; gu32* ctl = WP(gu32, WS_CTL); bf16* H = WP(bf16, WS_H);
            for (;;) {
                __syncthreads(); if (tid == 0) *uq = __hip_atomic_fetch_add(ctl + CW_Q + 64 * (L * 4 + 2), 1u, RLX_AGENT); __syncthreads();
                const int u = (int)*uq; if (u >= 2560) break;
                AttnDesc d; d.K2 = nullptr; d.cosT = nullptr; d.sinT = nullptr; d.ldq = NINP; d.ldk = NINP; d.ldk2 = 0; d.ldv = NINP; d.ldo = 1024; d.pos0 = 0; d.scale = 0.08838834764831845f;
                if (u < 1024) {
                    const int qb = 31 - u / 32, v = u % 32, b = v / 16, vh = v % 16, hd = vh / 4, map = (vh / 2) % 2, half = vh % 2;
                    d.Q = H + C_DQ + hd * 256 + map * 128; d.K = H + C_DK + hd * 256 + map * 128; d.V = H + C_DV + hd * 256 + half * 128; d.O = WP(bf16, WS_DO) + (size_t)map * NTOK * 1024 + hd * 256 + half * 128; d.LSE = nullptr; d.lse_ld = 0;
                    d.row0 = b * SEQ; d.rstride = 1; d.iq0 = qb * 256; d.W = 1 << 29;
                } else {
                    const int w = u - 1024, b = w / 768, r = w % 768, hd = r / 96, r2 = r % 96, br = r2 / 32, idx = r2 % 32;
                    const int dil = br == 0 ? 1 : (br == 1 ? 4 : 16), nqb = 32 / dil, res = idx / nqb, qb = idx % nqb;
                    d.Q = H + C_BQ + hd * 128; d.K = H + C_BK + hd * 128; d.V = H + C_BV + hd * 128; d.O = WP(bf16, WS_DP) + (size_t)br * NTOK * 1024 + hd * 128; d.LSE = WP(float, WS_LSE) + (size_t)br * NTOK * 8 + hd; d.lse_ld = 8;
                    d.row0 = b * SEQ + res; d.rstride = dil; d.iq0 = qb * 256; d.W = 128;
                }
                attn_unit<128, 0, false>(lds, d, tid, wave, lane);
            } }
        }
        GRIDBAR();
        PH_ON(5) { WSL; const float lam_init = (L == 0) ? 0.2f : 0.35550906f;
          combine_rows(WP(bf16, WS_DP), WP(float, WS_LSE), WP(bf16, WS_DO), args.in[8] + (size_t)L * 512, args.in[9] + (size_t)L * 256, lam_init, WP(bf16, WS_MIX), gw, ngw, lane); }
        GRIDBAR();
        PH_ON(6) { WSL; pg8::Gemm g{WP(bf16, WS_MIX), WP(bf16, WS_WO), NTOK, DM, DM, DM}; pg8::StaticOrder S; S.init(NTOK, DM, G, (int)blockIdx.x); EpiF<0> E{WP(float, WS_Y), nullptr, DM};
          pg8::gemm_phase<EpiF<0>, pg8::StaticOrder, true, true>(lds, g, S, E); }
        GRIDBAR();
        PH_ON(7) { WSL; ln_rows(L == 0 ? args.in[0] : args.out, WP(float, WS_Y), args.in[10] + (size_t)L * DM, args.in[11] + (size_t)L * DM, args.out, WP(bf16, WS_XB), gw, ngw, lane); }
        GRIDBAR();
        PH_ON(8) { WSL; pg8::Gemm g{WP(bf16, WS_XB), WP(bf16, WS_FF1), NTOK, DFF, DM, DM}; pg8::StaticOrder S; S.init(NTOK, DFF, G, (int)blockIdx.x); EpiB<2> E{WP(bf16, WS_H), DFF, nullptr};
          pg8::gemm_phase<EpiB<2>, pg8::StaticOrder, true, true>(lds, g, S, E); }
        GRIDBAR();
        PH_ON(9) { WSL; pg8::Gemm g{WP(bf16, WS_H), WP(bf16, WS_FF2), NTOK, DM, DFF, DFF}; pg8::StaticOrder S; S.init(NTOK, DM, G, (int)blockIdx.x); EpiF<0> E{WP(float, WS_Y), nullptr, DM};
          pg8::gemm_phase<EpiF<0>, pg8::StaticOrder, true, true>(lds, g, S, E); }
        GRIDBAR();
        PH_ON(10) {
        { WSL; ln_rows(args.out, WP(float, WS_Y), args.in[14] + (size_t)L * DM, args.in[15] + (size_t)L * DM, args.out, WP(bf16, WS_XB), gw, ngw, lane); }
        __syncthreads();
        { WSL; pg8::Gemm g{WP(bf16, WS_PB), WP(bf16, WS_PROJ), NTOK, DM, PLE, PLE}; pg8::StaticOrder S; S.init(NTOK, DM, G, (int)blockIdx.x); EpiF<0> E{WP(float, WS_H), nullptr, DM};
          pg8::gemm_phase<EpiF<0>, pg8::StaticOrder, true, true>(lds, g, S, E); }
        }
        GRIDBAR();
        PH_ON(11) { WSL; pg8::Gemm g{WP(bf16, WS_XB), WP(bf16, WS_GATE), NTOK, DM, DM, DM}; pg8::StaticOrder S; S.init(NTOK, DM, G, (int)blockIdx.x); EpiF<1> E{WP(float, WS_Y), WP(float, WS_H), DM};
          pg8::gemm_phase<EpiF<1>, pg8::StaticOrder, true, true>(lds, g, S, E); }
        GRIDBAR();
        PH_ON(12) { WSL; ln_rows(args.out, WP(float, WS_Y), args.in[18] + (size_t)L * DM, args.in[19] + (size_t)L * DM, args.out, WP(bf16, WS_XB), gw, ngw, lane); }

        xcd_barrier(bar);
    }
    { constexpr int L = 1; constexpr int PH = -1;

        PH_ON(0) {
            WSL; const size_t gtid = (size_t)blockIdx.x * 512 + tid, gthreads = (size_t)G * 512;
            LAS float* scr = (LAS float*)(lds + wave * 16384);
            constexpr int I_IN = 64 * (NIN / 32), I_O = 64 * 128, I_UQ = 16 * 48, I_UKV = 8 * 64, I_F1 = 64 * 512, I_F2 = 256 * 128, I_G = 64 * 128, I_P = 4 * 128;
            constexpr int NITEMS = I_IN + I_O + I_UQ + I_UKV + I_F1 + I_F2 + I_G + I_P;
            for (int it = gw; it < NITEMS; it += ngw) {
                int r = it;
                if (r < I_IN) { transpose_item(args.in[2] + (size_t)L * DM * NIN, DM, NIN, WP(bf16, WS_WIN), nullptr, scr, r, lane); continue; } r -= I_IN;
                if (r < I_O) { transpose_item(args.in[3] + (size_t)L * DM * DM, DM, DM, WP(bf16, WS_WO), nullptr, scr, r, lane); continue; } r -= I_O;
                if (r < I_UQ) { transpose_item(args.in[5] + (size_t)L * 1024 * 1536, 1024, 1536, WP(bf16, WS_UQ), args.in[4] + (size_t)L * 1024, scr, r, lane); continue; } r -= I_UQ;
                if (r < I_UKV) { transpose_item(args.in[7] + (size_t)L * 512 * 2048, 512, 2048, WP(bf16, WS_UKV), args.in[6] + (size_t)L * 512, scr, r, lane); continue; } r -= I_UKV;
                if (r < I_F1) { transpose_item(args.in[12] + (size_t)L * DM * DFF, DM, DFF, WP(bf16, WS_FF1), nullptr, scr, r, lane); continue; } r -= I_F1;
                if (r < I_F2) { transpose_item(args.in[13] + (size_t)L * DFF * DM, DFF, DM, WP(bf16, WS_FF2), nullptr, scr, r, lane); continue; } r -= I_F2;
                if (r < I_G) { transpose_item(args.in[16] + (size_t)L * DM * DM, DM, DM, WP(bf16, WS_GATE), nullptr, scr, r, lane); continue; } r -= I_G;
                transpose_item(args.in[17] + (size_t)L * PLE * DM, PLE, DM, WP(bf16, WS_PROJ), nullptr, scr, r, lane);
            }
            { v4u z = {0u, 0u, 0u, 0u}; v4u* pad = (v4u*)(WP(bf16, WS_WIN) + (size_t)NIN * DM); const size_t n16 = (size_t)(NINP - NIN) * DM / 8; for (size_t i = gtid; i < n16; i += gthreads) pad[i] = z; }
            cvt_rows(args.in[1] + (size_t)L * NTOK * PLE, WP(bf16, WS_PB), (size_t)NTOK * PLE / 8, gtid, gthreads);
            if (L == 0) {
                cvt_rows(args.in[0], WP(bf16, WS_XB), (size_t)NTOK * DM / 8, gtid, gthreads);
                float* cos128 = WP(float, WS_COS128); float* sin128 = WP(float, WS_SIN128); float* cos64 = WP(float, WS_COS64); float* sin64 = WP(float, WS_SIN64);
                for (size_t i = gtid; i < (size_t)SEQ * 64; i += gthreads) { const int pos = (int)(i >> 6), j = (int)(i & 63); const float inv = powf(10000.0f, -(float)j / 64.0f); const float ang = (float)pos * inv; cos128[i] = cosf(ang); sin128[i] = sinf(ang); }
                for (size_t i = gtid; i < (size_t)SEQ * 32; i += gthreads) { const int pos = (int)(i >> 5), j = (int)(i & 31); const float inv = powf(10000.0f, -(float)j / 32.0f); const float ang = (float)pos * inv; cos64[i] = cosf(ang); sin64[i] = sinf(ang); }
            }
        }
        GRIDBAR();
        PH_ON(1) { WSL; pg8::Gemm g{WP(bf16, WS_XB), WP(bf16, WS_WIN), NTOK, NINP, DM, DM}; pg8::StaticOrder S; S.init(NTOK, NINP, G, (int)blockIdx.x); EpiB<0> E{WP(bf16, WS_H), NINP, nullptr};
          pg8::gemm_phase<EpiB<0>, pg8::StaticOrder, true, true>(lds, g, S, E); }
        GRIDBAR();
        PH_ON(2) { WSL; rope_rows(WP(bf16, WS_H), WP(float, WS_COS128), WP(float, WS_SIN128), WP(float, WS_COS64), WP(float, WS_SIN64), WP(float, WS_RSQ), WP(float, WS_RSKV), gw, ngw, lane); }
        GRIDBAR();
        PH_ON(3) {
        { WSL; pg8::Gemm g{WP(bf16, WS_H) + C_CQ, WP(bf16, WS_UQ), NTOK, 1536, 1024, NINP}; pg8::StaticOrder S; S.init(NTOK, 1536, G, (int)blockIdx.x); EpiB<0> E{WP(bf16, WS_QM), 1536, WP(float, WS_RSQ)};
          pg8::gemm_phase<EpiB<0>, pg8::StaticOrder, true, true>(lds, g, S, E); }
        __syncthreads();
        { WSL; pg8::Gemm g{WP(bf16, WS_H) + C_CKV, WP(bf16, WS_UKV), NTOK, 2048, 512, NINP}; pg8::StaticOrder S; S.init(NTOK, 2048, G, (int)blockIdx.x); EpiB<0> E{WP(bf16, WS_KVM), 2048, WP(float, WS_RSKV)};
          pg8::gemm_phase<EpiB<0>, pg8::StaticOrder, true, true>(lds, g, S, E); }
        }
        GRIDBAR();
        PH_ON(4) {
            LAS unsigned* uq = (LAS unsigned*)(lds + MISC_OFF + 64);
            { WSL; gu32* ctl = WP(gu32, WS_CTL); bf16* H = WP(bf16, WS_H); bf16* MIX = WP(bf16, WS_MIX);
            for (;;) {
                __syncthreads(); if (tid == 0) *uq = __hip_atomic_fetch_add(ctl + CW_Q + 64 * (L * 4 + 0), 1u, RLX_AGENT); __syncthreads();
                const int u = (int)*uq; if (u >= 512) break;
                const int qb = 31 - u / 16, bh = u % 16, b = bh / 8, hd = bh % 8;
                AttnDesc d; d.Q = H + C_AQ + hd * 128; d.K = H + C_AK + hd * 128; d.K2 = nullptr; d.V = H + C_AV + hd * 128; d.O = MIX + hd * 128; d.LSE = nullptr; d.cosT = nullptr; d.sinT = nullptr;
                d.ldq = NINP; d.ldk = NINP; d.ldk2 = 0; d.ldv = NINP; d.ldo = DM; d.lse_ld = 0; d.row0 = b * SEQ; d.rstride = 1; d.iq0 = qb * 256; d.W = 1 << 29; d.pos0 = 0; d.scale = 0.08838834764831845f;
                attn_unit<128, 1, false>(lds, d, tid, wave, lane);
            } }
            { WSL; gu32* ctl = WP(gu32, WS_CTL); bf16* QM = WP(bf16, WS_QM); bf16* KVM = WP(bf16, WS_KVM);
            for (;;) {
                __syncthreads(); if (tid == 0) *uq = __hip_atomic_fetch_add(ctl + CW_Q + 64 * (L * 4 + 1), 1u, RLX_AGENT); __syncthreads();
                const int u = (int)*uq; if (u >= 512) break;
                const int qb = 31 - u / 16, bh = u % 16, b = bh / 8, hd = bh % 8;
                AttnDesc d; d.Q = QM + hd * 192; d.K = KVM + hd * 256; d.K2 = WP(bf16, WS_H) + C_CKR; d.V = KVM + hd * 256 + 128; d.O = WP(bf16, WS_MIX) + 2048 + hd * 128; d.LSE = nullptr; d.cosT = WP(float, WS_COS64); d.sinT = WP(float, WS_SIN64);
                d.ldq = 1536; d.ldk = 2048; d.ldk2 = NINP; d.ldv = 2048; d.ldo = DM; d.lse_ld = 0; d.row0 = b * SEQ; d.rstride = 1; d.iq0 = qb * 256; d.W = 1 << 29; d.pos0 = 0; d.scale = 0.07216878364870323f;
                attn_unit<192, 0, true>(lds, d, tid, wave, lane);
            } }
            { WSL; gu32* ctl = WP(gu32, WS_CTL); bf16* H = WP(bf16, WS_H);
            for (;;) {
                __syncthreads(); if (tid == 0) *uq = __hip_atomic_fetch_add(ctl + CW_Q + 64 * (L * 4 + 2), 1u, RLX_AGENT); __syncthreads();
                const int u = (int)*uq; if (u >= 2560) break;
                AttnDesc d; d.K2 = nullptr; d.cosT = nullptr; d.sinT = nullptr; d.ldq = NINP; d.ldk = NINP; d.ldk2 = 0; d.ldv = NINP; d.ldo = 1024; d.pos0 = 0; d.scale = 0.08838834764831845f;
                if (u < 1024) {
                    const int qb = 31 - u / 32, v = u % 32, b = v / 16, vh = v % 16, hd = vh / 4, map = (vh / 2) % 2, half = vh % 2;
                    d.Q = H + C_DQ + hd * 256 + map * 128; d.K = H + C_DK + hd * 256 + map * 128; d.V = H + C_DV + hd * 256 + half * 128; d.O = WP(bf16, WS_DO) + (size_t)map * NTOK * 1024 + hd * 256 + half * 128; d.LSE = nullptr; d.lse_ld = 0;
                    d.row0 = b * SEQ; d.rstride = 1; d.iq0 = qb * 256; d.W = 1 << 29;
                } else {
                    const int w = u - 1024, b = w / 768, r = w % 768, hd = r / 96, r2 = r % 96, br = r2 / 32, idx = r2 % 32;
                    const int dil = br == 0 ? 1 : (br == 1 ? 4 : 16), nqb = 32 / dil, res = idx / nqb, qb = idx % nqb;
                    d.Q = H + C_BQ + hd * 128; d.K = H + C_BK + hd * 128; d.V = H + C_BV + hd * 128; d.O = WP(bf16, WS_DP) + (size_t)br * NTOK * 1024 + hd * 128; d.LSE = WP(float, WS_LSE) + (size_t)br * NTOK * 8 + hd; d.lse_ld = 8;
                    d.row0 = b * SEQ + res; d.rstride = dil; d.iq0 = qb * 256; d.W = 128;
                }
                attn_unit<128, 0, false>(lds, d, tid, wave, lane);
            } }
        }
        GRIDBAR();
        PH_ON(5) { WSL; const float lam_init = (L == 0) ? 0.2f : 0.35550906f;
          combine_rows(WP(bf16, WS_DP), WP(float, WS_LSE), WP(bf16, WS_DO), args.in[8] + (size_t)L * 512, args.in[9] + (size_t)L * 256, lam_init, WP(bf16, WS_MIX), gw, ngw, lane); }
        GRIDBAR();
        PH_ON(6) { WSL; pg8::Gemm g{WP(bf16, WS_MIX), WP(bf16, WS_WO), NTOK, DM, DM, DM}; pg8::StaticOrder S; S.init(NTOK, DM, G, (int)blockIdx.x); EpiF<0> E{WP(float, WS_Y), nullptr, DM};
          pg8::gemm_phase<EpiF<0>, pg8::StaticOrder, true, true>(lds, g, S, E); }
        GRIDBAR();
        PH_ON(7) { WSL; ln_rows(L == 0 ? args.in[0] : args.out, WP(float, WS_Y), args.in[10] + (size_t)L * DM, args.in[11] + (size_t)L * DM, args.out, WP(bf16, WS_XB), gw, ngw, lane); }
        GRIDBAR();
        PH_ON(8) { WSL; pg8::Gemm g{WP(bf16, WS_XB), WP(bf16, WS_FF1), NTOK, DFF, DM, DM}; pg8::StaticOrder S; S.init(NTOK, DFF, G, (int)blockIdx.x); EpiB<2> E{WP(bf16, WS_H), DFF, nullptr};
          pg8::gemm_phase<EpiB<2>, pg8::StaticOrder, true, true>(lds, g, S, E); }
        GRIDBAR();
        PH_ON(9) { WSL; pg8::Gemm g{WP(bf16, WS_H), WP(bf16, WS_FF2), NTOK, DM, DFF, DFF}; pg8::StaticOrder S; S.init(NTOK, DM, G, (int)blockIdx.x); EpiF<0> E{WP(float, WS_Y), nullptr, DM};
          pg8::gemm_phase<EpiF<0>, pg8::StaticOrder, true, true>(lds, g, S, E); }
        GRIDBAR();
        PH_ON(10) {
        { WSL; ln_rows(args.out, WP(float, WS_Y), args.in[14] + (size_t)L * DM, args.in[15] + (size_t)L * DM, args.out, WP(bf16, WS_XB), gw, ngw, lane); }
        __syncthreads();
        { WSL; pg8::Gemm g{WP(bf16, WS_PB), WP(bf16, WS_PROJ), NTOK, DM, PLE, PLE}; pg8::StaticOrder S; S.init(NTOK, DM, G, (int)blockIdx.x); EpiF<0> E{WP(float, WS_H), nullptr, DM};
          pg8::gemm_phase<EpiF<0>, pg8::StaticOrder, true, true>(lds, g, S, E); }
        }
        GRIDBAR();
        PH_ON(11) { WSL; pg8::Gemm g{WP(bf16, WS_XB), WP(bf16, WS_GATE), NTOK, DM, DM, DM}; pg8::StaticOrder S; S.init(NTOK, DM, G, (int)blockIdx.x); EpiF<1> E{WP(float, WS_Y), WP(float, WS_H), DM};
          pg8::gemm_phase<EpiF<1>, pg8::StaticOrder, true, true>(lds, g, S, E); }
        GRIDBAR();
        PH_ON(12) { WSL; ln_rows(args.out, WP(float, WS_Y), args.in[18] + (size_t)L * DM, args.in[19] + (size_t)L * DM, args.out, WP(bf16, WS_XB), gw, ngw, lane); }

    }
}
#else
template <int PH> __global__ void __launch_bounds__(512, 2) hybrid_ph(Args args) {

    extern __shared__ __attribute__((aligned(16))) unsigned char lds_raw[];
    LAS unsigned char* lds = (LAS unsigned char*)lds_raw;
    volatile LAS unsigned* MISC = (volatile LAS unsigned*)(lds + MISC_OFF);
    const int tid = threadIdx.x, lane = tid & 63, wave = __builtin_amdgcn_readfirstlane(tid >> 6);
    const int G = gridDim.x, gw = blockIdx.x * NWAVES + wave, ngw = G * NWAVES;
    for (int u = tid; u < (LDS_BYTES - RING_BYTES) / 4; u += 512) ((LAS unsigned*)(lds + RING_BYTES))[u] = 0u;
    __syncthreads();

    XcdBarrier bar; bar.bar = nullptr; bar.x = 0; bar.st = nullptr; (void)bar; (void)MISC;
    const int L = args.L;

        PH_ON(0) {
            WSL; const size_t gtid = (size_t)blockIdx.x * 512 + tid, gthreads = (size_t)G * 512;
            LAS float* scr = (LAS float*)(lds + wave * 16384);
            constexpr int I_IN = 64 * (NIN / 32), I_O = 64 * 128, I_UQ = 16 * 48, I_UKV = 8 * 64, I_F1 = 64 * 512, I_F2 = 256 * 128, I_G = 64 * 128, I_P = 4 * 128;
            constexpr int NITEMS = I_IN + I_O + I_UQ + I_UKV + I_F1 + I_F2 + I_G + I_P;
            for (int it = gw; it < NITEMS; it += ngw) {
                int r = it;
                if (r < I_IN) { transpose_item(args.in[2] + (size_t)L * DM * NIN, DM, NIN, WP(bf16, WS_WIN), nullptr, scr, r, lane); continue; } r -= I_IN;
                if (r < I_O) { transpose_item(args.in[3] + (size_t)L * DM * DM, DM, DM, WP(bf16, WS_WO), nullptr, scr, r, lane); continue; } r -= I_O;
                if (r < I_UQ) { transpose_item(args.in[5] + (size_t)L * 1024 * 1536, 1024, 1536, WP(bf16, WS_UQ), args.in[4] + (size_t)L * 1024, scr, r, lane); continue; } r -= I_UQ;
                if (r < I_UKV) { transpose_item(args.in[7] + (size_t)L * 512 * 2048, 512, 2048, WP(bf16, WS_UKV), args.in[6] + (size_t)L * 512, scr, r, lane); continue; } r -= I_UKV;
                if (r < I_F1) { transpose_item(args.in[12] + (size_t)L * DM * DFF, DM, DFF, WP(bf16, WS_FF1), nullptr, scr, r, lane); continue; } r -= I_F1;
                if (r < I_F2) { transpose_item(args.in[13] + (size_t)L * DFF * DM, DFF, DM, WP(bf16, WS_FF2), nullptr, scr, r, lane); continue; } r -= I_F2;
                if (r < I_G) { transpose_item(args.in[16] + (size_t)L * DM * DM, DM, DM, WP(bf16, WS_GATE), nullptr, scr, r, lane); continue; } r -= I_G;
                transpose_item(args.in[17] + (size_t)L * PLE * DM, PLE, DM, WP(bf16, WS_PROJ), nullptr, scr, r, lane);
            }
            { v4u z = {0u, 0u, 0u, 0u}; v4u* pad = (v4u*)(WP(bf16, WS_WIN) + (size_t)NIN * DM); const size_t n16 = (size_t)(NINP - NIN) * DM / 8; for (size_t i = gtid; i < n16; i += gthreads) pad[i] = z; }
            cvt_rows(args.in[1] + (size_t)L * NTOK * PLE, WP(bf16, WS_PB), (size_t)NTOK * PLE / 8, gtid, gthreads);
            if (L == 0) {
                cvt_rows(args.in[0], WP(bf16, WS_XB), (size_t)NTOK * DM / 8, gtid, gthreads);
                float* cos128 = WP(float, WS_COS128); float* sin128 = WP(float, WS_SIN128); float* cos64 = WP(float, WS_COS64); float* sin64 = WP(float, WS_SIN64);
                for (size_t i = gtid; i < (size_t)SEQ * 64; i += gthreads) { const int pos = (int)(i >> 6), j = (int)(i & 63); const float inv = powf(10000.0f, -(float)j / 64.0f); const float ang = (float)pos * inv; cos128[i] = cosf(ang); sin128[i] = sinf(ang); }
                for (size_t i = gtid; i < (size_t)SEQ * 32; i += gthreads) { const int pos = (int)(i >> 5), j = (int)(i & 31); const float inv = powf(10000.0f, -(float)j / 32.0f); const float ang = (float)pos * inv; cos64[i] = cosf(ang); sin64[i] = sinf(ang); }
            }
        }
        GRIDBAR();
        PH_ON(1) { WSL; pg8::Gemm g{WP(bf16, WS_XB), WP(bf16, WS_WIN), NTOK, NINP, DM, DM}; pg8::StaticOrder S; S.init(NTOK, NINP, G, (int)blockIdx.x); EpiB<0> E{WP(bf16, WS_H), NINP, nullptr};
          pg8::gemm_phase<EpiB<0>, pg8::StaticOrder, true, true>(lds, g, S, E); }
        GRIDBAR();
        PH_ON(2) { WSL; rope_rows(WP(bf16, WS_H), WP(float, WS_COS128), WP(float, WS_SIN128), WP(float, WS_COS64), WP(float, WS_SIN64), WP(float, WS_RSQ), WP(float, WS_RSKV), gw, ngw, lane); }
        GRIDBAR();
        PH_ON(3) {
        { WSL; pg8::Gemm g{WP(bf16, WS_H) + C_CQ, WP(bf16, WS_UQ), NTOK, 1536, 1024, NINP}; pg8::StaticOrder S; S.init(NTOK, 1536, G, (int)blockIdx.x); EpiB<0> E{WP(bf16, WS_QM), 1536, WP(float, WS_RSQ)};
          pg8::gemm_phase<EpiB<0>, pg8::StaticOrder, true, true>(lds, g, S, E); }
        __syncthreads();
        { WSL; pg8::Gemm g{WP(bf16, WS_H) + C_CKV, WP(bf16, WS_UKV), NTOK, 2048, 512, NINP}; pg8::StaticOrder S; S.init(NTOK, 2048, G, (int)blockIdx.x); EpiB<0> E{WP(bf16, WS_KVM), 2048, WP(float, WS_RSKV)};
          pg8::gemm_phase<EpiB<0>, pg8::StaticOrder, true, true>(lds, g, S, E); }
        }
        GRIDBAR();
        PH_ON(4) {
            LAS unsigned* uq = (LAS unsigned*)(lds + MISC_OFF + 64);
            { WSL; gu32* ctl = WP(gu32, WS_CTL); bf16* H = WP(bf16, WS_H); bf16* MIX = WP(bf16, WS_MIX);
            for (;;) {
                __syncthreads(); if (tid == 0) *uq = __hip_atomic_fetch_add(ctl + CW_Q + 64 * (L * 4 + 0), 1u, RLX_AGENT); __syncthreads();
                const int u = (int)*uq; if (u >= 512) break;
                const int qb = 31 - u / 16, bh = u % 16, b = bh / 8, hd = bh % 8;
                AttnDesc d; d.Q = H + C_AQ + hd * 128; d.K = H + C_AK + hd * 128; d.K2 = nullptr; d.V = H + C_AV + hd * 128; d.O = MIX + hd * 128; d.LSE = nullptr; d.cosT = nullptr; d.sinT = nullptr;
                d.ldq = NINP; d.ldk = NINP; d.ldk2 = 0; d.ldv = NINP; d.ldo = DM; d.lse_ld = 0; d.row0 = b * SEQ; d.rstride = 1; d.iq0 = qb * 256; d.W = 1 << 29; d.pos0 = 0; d.scale = 0.08838834764831845f;
                attn_unit<128, 1, false>(lds, d, tid, wave, lane);
            } }
            { WSL; gu32* ctl = WP(gu32, WS_CTL); bf16* QM = WP(bf16, WS_QM); bf16* KVM = WP(bf16, WS_KVM);
            for (;;) {
                __syncthreads(); if (tid == 0) *uq = __hip_atomic_fetch_add(ctl + CW_Q + 64 * (L * 4 + 1), 1u, RLX_AGENT); __syncthreads();
                const int u = (int)*uq; if (u >= 512) break;
                const int qb = 31 - u / 16, bh = u % 16, b = bh / 8, hd = bh % 8;
                AttnDesc d; d.Q = QM + hd * 192; d.K = KVM + hd * 256; d.K2 = WP(bf16, WS_H) + C_CKR; d.V = KVM + hd * 256 + 128; d.O = WP(bf16, WS_MIX) + 2048 + hd * 128; d.LSE = nullptr; d.cosT = WP(float, WS_COS64); d.sinT = WP(float, WS_SIN64);
                d.ldq = 1536; d.ldk = 2048; d.ldk2 = NINP; d.ldv = 2048; d.ldo = DM; d.lse_ld = 0; d.row0 = b * SEQ; d.rstride = 1; d.iq0 = qb * 256; d.W = 1 << 29; d.pos0 = 0; d.scale = 0.07216878364870323f;
                attn_unit<192, 0, true>(lds, d, tid, wave, lane);
            } }
            { WSL; gu32* ctl = WP(gu32, WS_CTL); bf16* H = WP(bf16, WS_H);
            for (;;) {
                __syncthreads(); if (tid == 0) *uq = __hip_atomic_fetch_add(ctl + CW_Q + 64 * (L * 4 + 2), 1u, RLX_AGENT); __syncthreads();
                const int u = (int)*uq; if (u >= 2560) break;
                AttnDesc d; d.K2 = nullptr; d.cosT = nullptr; d.sinT = nullptr; d.ldq = NINP; d.ldk = NINP; d.ldk2 = 0; d.ldv = NINP; d.ldo = 1024; d.pos0 = 0; d.scale = 0.08838834764831845f;
                if (u < 1024) {
                    const int qb = 31 - u / 32, v = u % 32, b = v / 16, vh = v % 16, hd = vh / 4, map = (vh / 2) % 2, half = vh % 2;
                    d.Q = H + C_DQ + hd * 256 + map * 128; d.K = H + C_DK + hd * 256 + map * 128; d.V = H + C_DV + hd * 256 + half * 128; d.O = WP(bf16, WS_DO) + (size_t)map * NTOK * 1024 + hd * 256 + half * 128; d.LSE = nullptr; d.lse_ld = 0;
                    d.row0 = b * SEQ; d.rstride = 1; d.iq0 = qb * 256; d.W = 1 << 29;
                } else {
                    const int w = u - 1024, b = w / 768, r = w % 768, hd = r / 96, r2 = r % 96, br = r2 / 32, idx = r2 % 32;
                    const int dil = br == 0 ? 1 : (br == 1 ? 4 : 16), nqb = 32 / dil, res = idx / nqb, qb = idx % nqb;
                    d.Q = H + C_BQ + hd * 128; d.K = H + C_BK + hd * 128; d.V = H + C_BV + hd * 128; d.O = WP(bf16, WS_DP) + (size_t)br * NTOK * 1024 + hd * 128; d.LSE = WP(float, WS_LSE) + (size_t)br * NTOK * 8 + hd; d.lse_ld = 8;
                    d.row0 = b * SEQ + res; d.rstride = dil; d.iq0 = qb * 256; d.W = 128;
                }
                attn_unit<128, 0, false>(lds, d, tid, wave, lane);
            } }
        }
        GRIDBAR();
        PH_ON(5) { WSL; const float lam_init = (L == 0) ? 0.2f : 0.35550906f;
          combine_rows(WP(bf16, WS_DP), WP(float, WS_LSE), WP(bf16, WS_DO), args.in[8] + (size_t)L * 512, args.in[9] + (size_t)L * 256, lam_init, WP(bf16, WS_MIX), gw, ngw, lane); }
        GRIDBAR();
        PH_ON(6) { WSL; pg8::Gemm g{WP(bf16, WS_MIX), WP(bf16, WS_WO), NTOK, DM, DM, DM}; pg8::StaticOrder S; S.init(NTOK, DM, G, (int)blockIdx.x); EpiF<0> E{WP(float, WS_Y), nullptr, DM};
          pg8::gemm_phase<EpiF<0>, pg8::StaticOrder, true, true>(lds, g, S, E); }
        GRIDBAR();
        PH_ON(7) { WSL; ln_rows(L == 0 ? args.in[0] : args.out, WP(float, WS_Y), args.in[10] + (size_t)L * DM, args.in[11] + (size_t)L * DM, args.out, WP(bf16, WS_XB), gw, ngw, lane); }
        GRIDBAR();
        PH_ON(8) { WSL; pg8::Gemm g{WP(bf16, WS_XB), WP(bf16, WS_FF1), NTOK, DFF, DM, DM}; pg8::StaticOrder S; S.init(NTOK, DFF, G, (int)blockIdx.x); EpiB<2> E{WP(bf16, WS_H), DFF, nullptr};
          pg8::gemm_phase<EpiB<2>, pg8::StaticOrder, true, true>(lds, g, S, E); }
        GRIDBAR();
        PH_ON(9) { WSL; pg8::Gemm g{WP(bf16, WS_H), WP(bf16, WS_FF2), NTOK, DM, DFF, DFF}; pg8::StaticOrder S; S.init(NTOK, DM, G, (int)blockIdx.x); EpiF<0> E{WP(float, WS_Y), nullptr, DM};
          pg8::gemm_phase<EpiF<0>, pg8::StaticOrder, true, true>(lds, g, S, E); }
        GRIDBAR();
        PH_ON(10) {
        { WSL; ln_rows(args.out, WP(float, WS_Y), args.in[14] + (size_t)L * DM, args.in[15] + (size_t)L * DM, args.out, WP(bf16, WS_XB), gw, ngw, lane); }
        __syncthreads();
        { WSL; pg8::Gemm g{WP(bf16, WS_PB), WP(bf16, WS_PROJ), NTOK, DM, PLE, PLE}; pg8::StaticOrder S; S.init(NTOK, DM, G, (int)blockIdx.x); EpiF<0> E{WP(float, WS_H), nullptr, DM};
          pg8::gemm_phase<EpiF<0>, pg8::StaticOrder, true, true>(lds, g, S, E); }
        }
        GRIDBAR();
        PH_ON(11) { WSL; pg8::Gemm g{WP(bf16, WS_XB), WP(bf16, WS_GATE), NTOK, DM, DM, DM}; pg8::StaticOrder S; S.init(NTOK, DM, G, (int)blockIdx.x); EpiF<1> E{WP(float, WS_Y), WP(float, WS_H), DM};
          pg8::gemm_phase<EpiF<1>, pg8::StaticOrder, true, true>(lds, g, S, E); }
        GRIDBAR();
        PH_ON(12) { WSL; ln_rows(args.out, WP(float, WS_Y), args.in[18] + (size_t)L * DM, args.in[19] + (size_t)L * DM, args.out, WP(bf16, WS_XB), gw, ngw, lane); }

}
template <int PH> static void launch_ph(int grid, hipStream_t stream, Args a) {
    static bool attr = false;
    if (!attr) { (void)hipFuncSetAttribute((const void*)hybrid_ph<PH>, hipFuncAttributeMaxDynamicSharedMemorySize, LDS_BYTES); attr = true; }
    hipLaunchKernelGGL(hybrid_ph<PH>, dim3(grid), dim3(512), LDS_BYTES, stream, a);
}
#endif

extern "C" void kernel_launch(void* const* d_in, const int* in_sizes, int n_in, void* d_out, int out_size, void* d_ws, size_t ws_size, hipStream_t stream) {
    static int grid = 0;
    if (grid == 0) {
        if (n_in != 20 || out_size != NTOK * DM || ws_size < WS_END) { fprintf(stderr, "kernel_launch: unexpected shapes (n_in %d out %d ws %zu)\n", n_in, out_size, ws_size); grid = -1; return; }
        int dev = 0, cus = 0;
        if (hipGetDevice(&dev) != hipSuccess || hipDeviceGetAttribute(&cus, hipDeviceAttributeMultiprocessorCount, dev) != hipSuccess) { grid = -1; return; }
#if ONE_LAUNCH
        int per_cu = 0;
        if (hipFuncSetAttribute((const void*)hybrid_one, hipFuncAttributeMaxDynamicSharedMemorySize, LDS_BYTES) != hipSuccess) { fprintf(stderr, "kernel_launch: hipFuncSetAttribute failed\n"); grid = -1; return; }
        if (hipOccupancyMaxActiveBlocksPerMultiprocessor(&per_cu, (const void*)hybrid_one, 512, LDS_BYTES) != hipSuccess || per_cu < 1) { fprintf(stderr, "kernel_launch: occupancy query says %d blocks per CU\n", per_cu); }
        (void)hipGetLastError();
#endif
        grid = cus;
    }
    if (grid < 0) return;
    if (hipMemsetAsync((char*)d_ws + WS_CTL, 0, CTL_ZERO_BYTES, stream) != hipSuccess) return;
    Args a{};
    for (int i = 0; i < 20; ++i) a.in[i] = (const float*)d_in[i];
    a.out = (float*)d_out; a.ws = (unsigned char*)d_ws; a.L = 0; a.pad = 0;
#if ONE_LAUNCH
    hipLaunchKernelGGL(hybrid_one, dim3(grid), dim3(512), LDS_BYTES, stream, a);
#else
    for (int L = 0; L < 2; ++L) { a.L = L;
        launch_ph<0>(grid, stream, a); launch_ph<1>(grid, stream, a); launch_ph<2>(grid, stream, a); launch_ph<3>(grid, stream, a); launch_ph<4>(grid, stream, a); launch_ph<5>(grid, stream, a); launch_ph<6>(grid, stream, a);
        launch_ph<7>(grid, stream, a); launch_ph<8>(grid, stream, a); launch_ph<9>(grid, stream, a); launch_ph<10>(grid, stream, a); launch_ph<11>(grid, stream, a); launch_ph<12>(grid, stream, a); }
#endif
}
```

```cpp
#include <hip/hip_runtime.h>
#include <cstdio>
#include <cstdint>
namespace pg8 {
#define PG8_LAS __attribute__((address_space(3)))
typedef unsigned short bf16_t;
typedef short bf16x8 __attribute__((ext_vector_type(8)));
typedef float f32x4 __attribute__((ext_vector_type(4)));
typedef unsigned u32x4 __attribute__((ext_vector_type(4)));
constexpr int BM = 256, BK = 64, HALF = 128, HTB = HALF * BK * 2  , STAGE_BYTES = 8 * HTB, NXCD = 8, WGM = 8;

__host__ __device__ __forceinline__ int lds_byte(int r, int c) { const int st = (r >> 4) * 2 + (c >> 5), rr = r & 15, cc = c & 31, ob = rr * 64 + cc * 2; return st * 1024 + (ob ^ (((ob >> 9) & 1) << 5)); }
__host__ __device__ __forceinline__ void stage_rc(int b, int& R, int& C) { const int st = b / 1024, sb = b % 1024, swz = sb ^ (((sb >> 9) & 1) << 5); R = (st >> 1) * 16 + swz / 64; C = (st & 1) * 32 + (swz % 64) / 2; }
__host__ __device__ __forceinline__ int perm32(int rho) { const int n = rho >> 4, i = rho & 15; return 8 * (i >> 2) + 4 * n + (i & 3); }

struct Unit { int pm, pn; };
struct Gemm { const bf16_t* A; const bf16_t* Bt; int M, N, K, lda; };

struct StaticOrder {
    int nM, nN, nwg, G, c;
    __host__ __device__ void init(int M, int N, int G_, int c_) { nM = M / BM; nN = N / BM; nwg = nM * nN; G = G_; c = c_; }
    __host__ __device__ bool next(int i, Unit& u) const {
        const long L = (long)i * G + c; if (L >= nwg) return false;
        int wgid = (int)L; { const int q = nwg / NXCD, r = nwg % NXCD, xcd = wgid % NXCD, off = wgid / NXCD; wgid = (xcd < r ? xcd * (q + 1) : r * (q + 1) + (xcd - r) * q) + off; }
        const int nig = WGM * nN, gid = wgid / nig, fm = gid * WGM, gsz = (nM - fm) < WGM ? (nM - fm) : WGM;
        u.pm = fm + ((wgid % nig) % gsz); u.pn = (wgid % nig) / gsz; return true;
    }
    __device__ __forceinline__ void a_ready(const Unit&) const {}
    __device__ __forceinline__ void done(const Unit&) const {}
};

__device__ __forceinline__ unsigned cvt_pk_bf16(float lo, float hi) { unsigned r; asm volatile("v_cvt_pk_bf16_f32 %0, %1, %2" : "=v"(r) : "v"(lo), "v"(hi)); return r; }
typedef float f32x2 __attribute__((ext_vector_type(2)));
__device__ __forceinline__ f32x2 gelu_pk(f32x2 v) {
    const f32x2 av = __builtin_elementwise_abs(v), d = av * 0.2316418882f + 1.0f;
    f32x2 t; t.x = __builtin_amdgcn_rcpf(d.x); t.y = __builtin_amdgcn_rcpf(d.y);
    f32x2 q = t * 0.5307027145f + (-0.7265760135f); q = q * t + 0.7107068705f; q = q * t + (-0.142248368f); q = q * t + 0.127414796f; q = q * t;
    const f32x2 s = (v * v) * (-0.72134752044f);
    f32x2 e; e.x = __builtin_amdgcn_exp2f(s.x); e.y = __builtin_amdgcn_exp2f(s.y);
    const f32x2 m = v * (q * e), r = v - m;
    f32x2 o; o.x = v.x < 0.f ? m.x : r.x; o.y = v.y < 0.f ? m.y : r.y; return o;
}

template <int ACT  > struct EpiBf16 {
    static constexpr bool PERM = true, AFTER_DRAIN = false; static_assert(ACT == 0 || ACT == 1, "EpiBf16: ACT is 0 (none) or 1 (gelu_pk)");
    bf16_t* O; int ldc; const float* bias; int split_cols; size_t split_stride; float scale0;
    __device__ __forceinline__ void operator()(const f32x4 (&acc)[2][2][4][2], const Unit& u, int wr, int wc, int fr, int fq) const {
        const int row0 = u.pm * BM + wr * 64 + fr; int colt = u.pn * BM; bf16_t* base = O;
        float sc = 1.f; if (split_cols) { const int t = colt / split_cols; base += (size_t)t * split_stride; colt -= t * split_cols; if (t == 0) sc = scale0; }
        const int col0 = colt + wc * 32 + 8 * fq, bcol0 = u.pn * BM + wc * 32 + 8 * fq;
        f32x4 bv[2][2];
#pragma unroll
        for (int bj = 0; bj < 2; ++bj)
#pragma unroll
            for (int n = 0; n < 2; ++n) bv[bj][n] = bias ? *(const f32x4*)(bias + bcol0 + bj * HALF + 4 * n) : (f32x4){0.f, 0.f, 0.f, 0.f};
#pragma unroll
        for (int ai = 0; ai < 2; ++ai)
#pragma unroll
            for (int m = 0; m < 4; ++m) { bf16_t* rowp = base + (size_t)(row0 + ai * HALF + m * 16) * ldc + col0;
#pragma unroll
                for (int bj = 0; bj < 2; ++bj) { f32x4 v0 = acc[ai][bj][m][0] + bv[bj][0], v1 = acc[ai][bj][m][1] + bv[bj][1];
                    if (ACT == 1) { f32x2 a = gelu_pk((f32x2){v0[0], v0[1]}), b = gelu_pk((f32x2){v0[2], v0[3]}), c = gelu_pk((f32x2){v1[0], v1[1]}), d = gelu_pk((f32x2){v1[2], v1[3]});
                        v0 = (f32x4){a.x, a.y, b.x, b.y}; v1 = (f32x4){c.x, c.y, d.x, d.y}; }
                    v0 = v0 * sc; v1 = v1 * sc; u32x4 w; w.x = cvt_pk_bf16(v0[0], v0[1]); w.y = cvt_pk_bf16(v0[2], v0[3]); w.z = cvt_pk_bf16(v1[0], v1[1]); w.w = cvt_pk_bf16(v1[2], v1[3]);
                    *(u32x4*)(rowp + bj * HALF) = w; } }
    }
};

struct PanelStats {
    unsigned* xbuf;
    unsigned* cnt;
    unsigned* tmo;
    int ntn; float eps;
    unsigned code;
    __device__ __forceinline__ bool run(const f32x4 (&v)[2][2][4][2], const Unit& u, int wr, int wc, int fr, int fq, PG8_LAS unsigned char* lds, int wid, int lane) const {
        typedef float f32x2v __attribute__((ext_vector_type(2)));
        PG8_LAS f32x2v* P = (PG8_LAS f32x2v*)lds;
        PG8_LAS f32x2v* S = (PG8_LAS f32x2v*)(lds + 8192);
        PG8_LAS unsigned* flag = (PG8_LAS unsigned*)(lds + 8192 + 2048);
#pragma unroll
        for (int ai = 0; ai < 2; ++ai)
#pragma unroll
            for (int m = 0; m < 4; ++m) {
                float s = 0.f;
#pragma unroll
                for (int bj = 0; bj < 2; ++bj)
#pragma unroll
                    for (int n = 0; n < 2; ++n) { const f32x4 x = v[ai][bj][m][n]; s += (x[0] + x[1]) + (x[2] + x[3]); }
                s += __shfl_xor(s, 16); s += __shfl_xor(s, 32);
                const float mw = s * (1.0f / 64.0f); float q = 0.f;
#pragma unroll
                for (int bj = 0; bj < 2; ++bj)
#pragma unroll
                    for (int n = 0; n < 2; ++n) { const f32x4 d = v[ai][bj][m][n] - mw; q += (d[0] * d[0] + d[1] * d[1]) + (d[2] * d[2] + d[3] * d[3]); }
                q += __shfl_xor(q, 16); q += __shfl_xor(q, 32);
                if (fq == 0) P[(ai * HALF + wr * 64 + m * 16 + fr) * 4 + wc] = (f32x2v){mw, q};
            }
        asm volatile("s_waitcnt lgkmcnt(0)" ::: "memory"); __builtin_amdgcn_s_barrier(); asm volatile("" ::: "memory");
#if defined(BROKEN_EXCHANGE_NO_WAIT)
#warning BROKEN CONTROL BUILD: the row-statistics exchange does not wait; results are wrong by design
        if (blockIdx.x >= 64) { const long long t0_ = clock64(); while (clock64() - t0_ < 60000) __builtin_amdgcn_s_sleep(8); }
#endif
        const int row = wid * 32 + (lane & 31);
        if (lane < 32) {
            const f32x2v a = P[row * 4 + 0], b = P[row * 4 + 1], c = P[row * 4 + 2], d = P[row * 4 + 3];
            const float mt = (a.x + b.x + c.x + d.x) * 0.25f;
            const float da = a.x - mt, db = b.x - mt, dc = c.x - mt, dd = d.x - mt;
            const float m2 = (a.y + b.y) + (c.y + d.y) + 64.0f * ((da * da + db * db) + (dc * dc + dd * dd));
            unsigned long long* slot = (unsigned long long*)xbuf + ((size_t)(u.pm * BM + row) * 4 + u.pn);
            __hip_atomic_store(slot, ((unsigned long long)__float_as_uint(m2) << 32) | __float_as_uint(mt), __ATOMIC_RELAXED, __HIP_MEMORY_SCOPE_AGENT);
        }
        asm volatile("s_waitcnt vmcnt(0)" ::: "memory");
        if (lane == 0) __hip_atomic_fetch_add(cnt + 64 * u.pm, 1u, __ATOMIC_RELAXED, __HIP_MEMORY_SCOPE_AGENT);
        if (wid == 0) {
            bool dead = false; const unsigned long long t0 = __builtin_amdgcn_s_memrealtime(); const unsigned want = 8u * (unsigned)ntn;
            for (;;) {
#if defined(BROKEN_EXCHANGE_NO_WAIT)
                break;
#endif
                if ((unsigned)__builtin_amdgcn_readfirstlane(__hip_atomic_load(cnt + 64 * u.pm, __ATOMIC_RELAXED, __HIP_MEMORY_SCOPE_AGENT)) >= want) break;
                if (__builtin_amdgcn_s_memrealtime() - t0 > 2000000ull) {
                    if (lane == 0) { unsigned expect = 0u; __hip_atomic_compare_exchange_strong(tmo + 1, &expect, code | (unsigned)(u.pm & 0xff), __ATOMIC_RELAXED, __ATOMIC_RELAXED, __HIP_MEMORY_SCOPE_AGENT);
                                     __hip_atomic_store(tmo, 1u, __ATOMIC_RELAXED, __HIP_MEMORY_SCOPE_AGENT); }
                    dead = true; break; }
                __builtin_amdgcn_s_sleep(2);
            }
            __builtin_amdgcn_fence(__ATOMIC_ACQUIRE, "agent");
            if (lane == 0) flag[0] = dead ? 1u : 0u;
        }
        asm volatile("s_waitcnt vmcnt(0) lgkmcnt(0)" ::: "memory"); __builtin_amdgcn_s_barrier(); asm volatile("" ::: "memory");
        const bool bad = flag[0] != 0u;
        if (lane < 32) {
            const unsigned long long* slot = (const unsigned long long*)xbuf + (size_t)(u.pm * BM + row) * 4; float mt[4], m2[4]; float ms = 0.f;
#pragma unroll
            for (int t = 0; t < 4; ++t) { if (t < ntn) { const unsigned long long w = __hip_atomic_load(slot + t, __ATOMIC_RELAXED, __HIP_MEMORY_SCOPE_AGENT); mt[t] = __uint_as_float((unsigned)w); m2[t] = __uint_as_float((unsigned)(w >> 32)); } else { mt[t] = 0.f; m2[t] = 0.f; } ms += mt[t]; }
            const float mean = ms / (float)ntn; float q = 0.f;
#pragma unroll
            for (int t = 0; t < 4; ++t) if (t < ntn) { const float dm = mt[t] - mean; q += m2[t] + 256.0f * dm * dm; }
            S[row] = (f32x2v){mean, 1.0f / sqrtf(q / (256.0f * (float)ntn) + eps)};
        }
        asm volatile("s_waitcnt lgkmcnt(0)" ::: "memory"); __builtin_amdgcn_s_barrier(); asm volatile("" ::: "memory");
        return bad;
    }
};
struct EpiLnRes {
    static constexpr bool PERM = false, AFTER_DRAIN = true;
    const float* base; float* out; int ldc; const float* bias; PanelStats st; unsigned poison;
    __device__ __forceinline__ void fused(f32x4 (&acc)[2][2][4][2], const Unit& u, int wr, int wc, int fr, int fq, PG8_LAS unsigned char* lds, int wid, int lane) const {
        typedef float f32x2v __attribute__((ext_vector_type(2)));
        const PG8_LAS f32x2v* S = (const PG8_LAS f32x2v*)(lds + 8192);
        const int col0 = u.pn * BM + wc * 32 + 4 * fq;
#pragma unroll
        for (int bj = 0; bj < 2; ++bj)
#pragma unroll
            for (int n = 0; n < 2; ++n) { const f32x4 bv = bias ? *(const f32x4*)(bias + col0 + bj * HALF + n * 16) : (f32x4){0.f, 0.f, 0.f, 0.f};
#pragma unroll
                for (int ai = 0; ai < 2; ++ai)
#pragma unroll
                    for (int m = 0; m < 4; ++m) acc[ai][bj][m][n] += bv; }
        f32x4 pre[4][2][2];
#pragma unroll
        for (int m = 0; m < 4; ++m) { const size_t off = (size_t)(u.pm * BM + wr * 64 + m * 16 + fr) * ldc + col0;
#pragma unroll
            for (int bj = 0; bj < 2; ++bj)
#pragma unroll
                for (int n = 0; n < 2; ++n) pre[m][bj][n] = *(const f32x4*)(base + off + bj * HALF + n * 16); }
        const bool bad = st.run(acc, u, wr, wc, fr, fq, lds, wid, lane) || poison != 0u;
        const float qnan = __builtin_nanf("");
#pragma unroll
        for (int ai = 0; ai < 2; ++ai)
#pragma unroll
            for (int m = 0; m < 4; ++m) { const int r = ai * HALF + wr * 64 + m * 16 + fr; const f32x2v sr = S[r]; const size_t off = (size_t)(u.pm * BM + r) * ldc + col0;
#pragma unroll
                for (int bj = 0; bj < 2; ++bj)
#pragma unroll
                    for (int n = 0; n < 2; ++n) { const f32x4 bs = ai == 0 ? pre[m][bj][n] : *(const f32x4*)(base + off + bj * HALF + n * 16); f32x4 o = bs + (acc[ai][bj][m][n] - sr.x) * sr.y;
                        if (bad) o = (f32x4){qnan, qnan, qnan, qnan}; *(f32x4*)(out + off + bj * HALF + n * 16) = o; }
                if (m & 1) asm volatile("" ::: "memory"); }
    }
};
struct EpiLnResLn {
    static constexpr bool PERM = false, AFTER_DRAIN = true;
    const float* base; float* out; bf16_t* xn; int ldc; const float* bias; PanelStats st1, st2; unsigned poison;
    __device__ __forceinline__ void fused(f32x4 (&acc)[2][2][4][2], const Unit& u, int wr, int wc, int fr, int fq, PG8_LAS unsigned char* lds, int wid, int lane) const {
        typedef float f32x2v __attribute__((ext_vector_type(2))); typedef unsigned u32x2v __attribute__((ext_vector_type(2)));
        const PG8_LAS f32x2v* S = (const PG8_LAS f32x2v*)(lds + 8192);
        const int col0 = u.pn * BM + wc * 32 + 4 * fq;
#pragma unroll
        for (int bj = 0; bj < 2; ++bj)
#pragma unroll
            for (int n = 0; n < 2; ++n) { const f32x4 bv = bias ? *(const f32x4*)(bias + col0 + bj * HALF + n * 16) : (f32x4){0.f, 0.f, 0.f, 0.f};
#pragma unroll
                for (int ai = 0; ai < 2; ++ai)
#pragma unroll
                    for (int m = 0; m < 4; ++m) acc[ai][bj][m][n] += bv; }
        bool bad = st1.run(acc, u, wr, wc, fr, fq, lds, wid, lane) || poison != 0u;
        const float qnan = __builtin_nanf("");
#pragma unroll
        for (int ai = 0; ai < 2; ++ai)
#pragma unroll
            for (int m = 0; m < 4; ++m) { const int r = ai * HALF + wr * 64 + m * 16 + fr; const f32x2v sr = S[r]; const size_t off = (size_t)(u.pm * BM + r) * ldc + col0;
#pragma unroll
                for (int bj = 0; bj < 2; ++bj)
#pragma unroll
                    for (int n = 0; n < 2; ++n) { const f32x4 bs = *(const f32x4*)(base + off + bj * HALF + n * 16); acc[ai][bj][m][n] = bs + (acc[ai][bj][m][n] - sr.x) * sr.y; }
                asm volatile("" : "+v"(acc[ai][0][m][0]), "+v"(acc[ai][0][m][1]), "+v"(acc[ai][1][m][0]), "+v"(acc[ai][1][m][1]));
                if (m & 1) asm volatile("" ::: "memory"); }
        const bool bad1 = bad;
        bad = st2.run(acc, u, wr, wc, fr, fq, lds, wid, lane) || bad;
#pragma unroll
        for (int ai = 0; ai < 2; ++ai)
#pragma unroll
            for (int m = 0; m < 4; ++m) { const int r = ai * HALF + wr * 64 + m * 16 + fr; const f32x2v sr = S[r]; const size_t off = (size_t)(u.pm * BM + r) * ldc + col0;
#pragma unroll
                for (int bj = 0; bj < 2; ++bj)
#pragma unroll
                    for (int n = 0; n < 2; ++n) { const f32x4 x1 = acc[ai][bj][m][n]; *(f32x4*)(out + off + bj * HALF + n * 16) = bad1 ? (f32x4){qnan, qnan, qnan, qnan} : x1;
                        const f32x4 o = (x1 - sr.x) * sr.y; u32x2v w; w.x = cvt_pk_bf16(o[0], o[1]); w.y = cvt_pk_bf16(o[2], o[3]);
                        if (bad) { w.x = 0x7fc07fc0u; w.y = 0x7fc07fc0u; } *(u32x2v*)(xn + off + bj * HALF + n * 16) = w; }
                asm volatile("" ::: "memory"); }
    }
};

template <class Epi, class Sched, bool ALIGN_EPI = false, bool SP2 = false>
__device__ __forceinline__ void gemm_phase(PG8_LAS unsigned char* lds, const Gemm g, const Sched& S, const Epi& E) {
    int tid = threadIdx.x; asm volatile("" : "+v"(tid));
    const int wid = __builtin_amdgcn_readfirstlane(tid >> 6), lane = tid & 63, wr = wid >> 2, wc = wid & 3, fr = lane & 15, fq = lane >> 4;
    const int K = g.K, nt = K / BK;
    unsigned voffA[2], voffB[2];
#pragma unroll
    for (int i = 0; i < 2; ++i) { int R, C; stage_rc(tid * 16 + i * 8192, R, C); const int Rb = Epi::PERM ? ((R & ~31) + perm32(R & 31)) : R;
        voffA[i] = (unsigned)(R * g.lda + C) * 2u; voffB[i] = (unsigned)(Rb * K + C) * 2u; }
    const size_t kstep = (size_t)(BK * 2);
    const size_t hstepB = (size_t)HALF * K * 2, hstepA = (size_t)HALF * g.lda * 2;
    const size_t tstepB = 2 * hstepB, tstepA = 2 * hstepA;
    const unsigned ldsw = (unsigned)wid * 1024u;
    const int aoff = lds_byte(wr * 64 + fr, fq * 8), boff = lds_byte(wc * 32 + fr, fq * 8);
#define PG8_SA(b, h) (((b) * 2 + (h)) * HTB)
#define PG8_SB(b, h) ((4 + (b) * 2 + (h)) * HTB)
#define PG8_STAGE(bufoff, gbase, voff) do { _Pragma("unroll") for (int _i = 0; _i < 2; ++_i) \
        __builtin_amdgcn_global_load_lds((const unsigned*)((const char*)(gbase) + (voff)[_i]), (PG8_LAS unsigned*)(lds + (bufoff) + ldsw + _i * 8192), 16, 0, 0); } while (0)
#define PG8_LDA(dst, b, h) do { _Pragma("unroll") for (int m = 0; m < 4; ++m) _Pragma("unroll") for (int k = 0; k < 2; ++k) dst[m][k] = *(const PG8_LAS bf16x8*)(lds + PG8_SA(b, h) + aoff + m * 2048 + k * 1024); } while (0)
#define PG8_LDB(dst, b, h) do { _Pragma("unroll") for (int n = 0; n < 2; ++n) _Pragma("unroll") for (int k = 0; k < 2; ++k) dst[n][k] = *(const PG8_LAS bf16x8*)(lds + PG8_SB(b, h) + boff + n * 2048 + k * 1024); } while (0)
#define PG8_MMA(ai, bj, At, Bt) do { __builtin_amdgcn_s_setprio(1); _Pragma("unroll") for (int m = 0; m < 4; ++m) _Pragma("unroll") for (int n = 0; n < 2; ++n) _Pragma("unroll") for (int k = 0; k < 2; ++k) \
        acc[ai][bj][m][n] = __builtin_amdgcn_mfma_f32_16x16x32_bf16(Bt[n][k], At[m][k], acc[ai][bj][m][n], 0, 0, 0); __builtin_amdgcn_s_setprio(0); } while (0)
#define PG8_WAIT_V(n) asm volatile("s_waitcnt vmcnt(" #n ")" ::: "memory")
#define PG8_WAIT_L(n) asm volatile("s_waitcnt lgkmcnt(" #n ")" ::: "memory")
#define PG8_BAR __builtin_amdgcn_s_barrier()
#define PG8_SCHED __builtin_amdgcn_sched_barrier(0)
    Unit cur, nxt; int ui = 0;
    if (!S.next(0, cur)) return;
    f32x4 acc[2][2][4][2];
#pragma unroll
    for (int a = 0; a < 2; ++a)
#pragma unroll
        for (int b = 0; b < 2; ++b)
#pragma unroll
            for (int m = 0; m < 4; ++m)
#pragma unroll
                for (int n = 0; n < 2; ++n) acc[a][b][m][n] = (f32x4){0.f, 0.f, 0.f, 0.f};
    bf16x8 At[4][2], B0[2][2], B1[2][2];
    const char* cA = (const char*)g.A + (size_t)cur.pm * tstepA; const char* cB = (const char*)g.Bt + (size_t)cur.pn * tstepB;
    S.a_ready(cur);
    if constexpr (SP2) {
        PG8_STAGE(PG8_SB(0, 0), cB, voffB); PG8_STAGE(PG8_SB(0, 1), cB + hstepB, voffB); PG8_STAGE(PG8_SA(0, 0), cA, voffA); PG8_STAGE(PG8_SA(0, 1), cA + hstepA, voffA);
        if (wr == 1) PG8_BAR;
        PG8_WAIT_V(2); PG8_BAR;
        PG8_STAGE(PG8_SB(1, 0), cB + kstep, voffB); PG8_STAGE(PG8_SA(1, 0), cA + kstep, voffA); PG8_STAGE(PG8_SB(1, 1), cB + hstepB + kstep, voffB);
        PG8_WAIT_V(6); PG8_BAR;
    } else {
        PG8_STAGE(PG8_SB(0, 0), cB, voffB); PG8_STAGE(PG8_SA(0, 0), cA, voffA); PG8_STAGE(PG8_SB(0, 1), cB + hstepB, voffB); PG8_STAGE(PG8_SA(0, 1), cA + hstepA, voffA);
        if (wr == 1) PG8_BAR;
        PG8_WAIT_V(4); PG8_BAR;
        PG8_STAGE(PG8_SB(1, 0), cB + kstep, voffB); PG8_STAGE(PG8_SA(1, 0), cA + kstep, voffA); PG8_STAGE(PG8_SB(1, 1), cB + hstepB + kstep, voffB);
        PG8_WAIT_V(6); PG8_BAR;
    }
    for (;;) {
        const bool has_next = S.next(ui + 1, nxt);
        const char* nA = has_next ? (const char*)g.A + (size_t)nxt.pm * tstepA : cA; const char* nB = has_next ? (const char*)g.Bt + (size_t)nxt.pn * tstepB : cB;
        for (int t = 0; t < nt; t += 2) {
            const bool last = (t == nt - 2);
            const char* a1 = cA + (size_t)(t + 1) * kstep;
            const char* a2 = last ? nA : cA + (size_t)(t + 2) * kstep; const char* b2 = last ? nB : cB + (size_t)(t + 2) * kstep;
            const char* a3 = a2 + kstep; const char* b3 = b2 + kstep;
            if (last && has_next) S.a_ready(nxt);
            if constexpr (SP2) {
            PG8_LDB(B0, 0, 0); PG8_LDB(B1, 0, 1); PG8_SCHED; PG8_LDA(At, 0, 0); PG8_STAGE(PG8_SA(1, 1), a1 + hstepA, voffA);
            PG8_WAIT_V(8); PG8_WAIT_L(0); PG8_BAR; PG8_MMA(0, 0, At, B0); PG8_MMA(0, 1, At, B1); PG8_BAR; PG8_SCHED;
            PG8_LDA(At, 0, 1); PG8_STAGE(PG8_SB(0, 0), b2, voffB); PG8_STAGE(PG8_SB(0, 1), b2 + hstepB, voffB); PG8_STAGE(PG8_SA(0, 0), a2, voffA);
            PG8_WAIT_V(8); PG8_WAIT_L(0); PG8_BAR; PG8_MMA(1, 0, At, B0); PG8_MMA(1, 1, At, B1); PG8_BAR; PG8_SCHED;
            PG8_LDB(B0, 1, 0); PG8_LDB(B1, 1, 1); PG8_SCHED; PG8_LDA(At, 1, 0); PG8_STAGE(PG8_SA(0, 1), a2 + hstepA, voffA);
            PG8_WAIT_V(8); PG8_WAIT_L(0); PG8_BAR; PG8_MMA(0, 0, At, B0); PG8_MMA(0, 1, At, B1); PG8_BAR; PG8_SCHED;
            PG8_LDA(At, 1, 1); PG8_STAGE(PG8_SB(1, 0), b3, voffB); PG8_STAGE(PG8_SB(1, 1), b3 + hstepB, voffB); PG8_STAGE(PG8_SA(1, 0), a3, voffA);
            PG8_WAIT_V(8); PG8_WAIT_L(0); PG8_BAR; PG8_MMA(1, 0, At, B0); PG8_MMA(1, 1, At, B1); PG8_BAR; PG8_SCHED;
            } else {
            PG8_LDB(B0, 0, 0); PG8_SCHED; PG8_LDA(At, 0, 0); PG8_STAGE(PG8_SA(1, 1), a1 + hstepA, voffA);
            PG8_WAIT_L(8); PG8_BAR; PG8_WAIT_L(0); PG8_MMA(0, 0, At, B0); PG8_BAR; PG8_SCHED;
            PG8_LDB(B1, 0, 1); PG8_STAGE(PG8_SB(0, 0), b2, voffB);
            PG8_BAR; PG8_WAIT_L(0); PG8_MMA(0, 1, At, B1); PG8_BAR;
            PG8_LDA(At, 0, 1); PG8_STAGE(PG8_SA(0, 0), a2, voffA);
            PG8_BAR; PG8_WAIT_L(0); PG8_MMA(1, 0, At, B0); PG8_BAR; PG8_SCHED;
            PG8_STAGE(PG8_SB(0, 1), b2 + hstepB, voffB);
            PG8_WAIT_V(6); PG8_BAR; PG8_MMA(1, 1, At, B1); PG8_BAR;
            PG8_LDB(B0, 1, 0); PG8_SCHED; PG8_LDA(At, 1, 0); PG8_STAGE(PG8_SA(0, 1), a2 + hstepA, voffA);
            PG8_WAIT_L(8); PG8_BAR; PG8_WAIT_L(0); PG8_MMA(0, 0, At, B0); PG8_BAR; PG8_SCHED;
            PG8_LDB(B1, 1, 1); PG8_STAGE(PG8_SB(1, 0), b3, voffB);
            PG8_BAR; PG8_WAIT_L(0); PG8_MMA(0, 1, At, B1); PG8_BAR;
            PG8_LDA(At, 1, 1); PG8_STAGE(PG8_SA(1, 0), a3, voffA);
            PG8_BAR; PG8_WAIT_L(0); PG8_MMA(1, 0, At, B0); PG8_BAR; PG8_SCHED;
            PG8_STAGE(PG8_SB(1, 1), b3 + hstepB, voffB);
            PG8_WAIT_V(6); PG8_BAR; PG8_MMA(1, 1, At, B1); PG8_BAR;
            }
        }
        if constexpr (ALIGN_EPI) { if (wr == 0) PG8_BAR; }
        if constexpr (!Epi::AFTER_DRAIN) { E(acc, cur, wr, wc, fr, fq); S.done(cur); }
        if (!has_next) break;
#pragma unroll
        for (int a = 0; a < 2; ++a)
#pragma unroll
            for (int b = 0; b < 2; ++b)
#pragma unroll
                for (int m = 0; m < 4; ++m)
#pragma unroll
                    for (int n = 0; n < 2; ++n) acc[a][b][m][n] = (f32x4){0.f, 0.f, 0.f, 0.f};
        cur = nxt; cA = nA; cB = nB; ++ui;
        if constexpr (ALIGN_EPI) { if (wr == 1) PG8_BAR; }
    }
    PG8_WAIT_V(0);
    if constexpr (!ALIGN_EPI) { if (wr == 0) PG8_BAR; }
    PG8_BAR;
    if constexpr (Epi::AFTER_DRAIN) { E.fused(acc, cur, wr, wc, fr, fq, lds, wid, lane); S.done(cur); }
#undef PG8_SA
#undef PG8_SB
#undef PG8_STAGE
#undef PG8_LDA
#undef PG8_LDB
#undef PG8_MMA
#undef PG8_WAIT_V
#undef PG8_WAIT_L
#undef PG8_BAR
#undef PG8_SCHED
}
}
#define GAS __attribute__((address_space(1)))
#define LAS __attribute__((address_space(3)))
typedef unsigned short bf16;
typedef unsigned v4u __attribute__((ext_vector_type(4)));
typedef float f32x4 __attribute__((ext_vector_type(4)));
typedef short bf16x8 __attribute__((ext_vector_type(8)));
typedef GAS unsigned gu32;
typedef GAS unsigned long long gu64;
#define RLX_AGENT __ATOMIC_RELAXED, __HIP_MEMORY_SCOPE_AGENT
#define LDS_WAIT() asm volatile("s_waitcnt lgkmcnt(0)" ::: "memory")
#define VM_WAIT() asm volatile("s_waitcnt vmcnt(0)" ::: "memory")
__device__ __forceinline__ unsigned long long rt() { return __builtin_amdgcn_s_memrealtime(); }
__device__ __forceinline__ unsigned f2bf(float f) { unsigned u = __builtin_bit_cast(unsigned, f); return (u + 0x7fffu + ((u >> 16) & 1u)) >> 16; }
typedef __bf16 hwbf2 __attribute__((ext_vector_type(2))); typedef float hwf2 __attribute__((ext_vector_type(2)));
__device__ __forceinline__ unsigned pk2(float lo, float hi) { hwf2 v = {lo, hi}; hwbf2 r = __builtin_convertvector(v, hwbf2); return __builtin_bit_cast(unsigned, r); }

#define XB_TMO      128
#define XB_XCNT(j)  (256  + 64 * (j))
#define XB_XSUB(j)  (1280 + 64 * (j))
#define XB_XGEN(j)  (2304 + 64 * (j))
#define XB_TOP      3328
#define XB_TOPGEN   3392
#define XCD_BAR_WORDS 3456
#define XB_SPIN_CAP (1u << 18)

__device__ __forceinline__ unsigned xb_ld(unsigned* p)              { return __hip_atomic_load(p, __ATOMIC_RELAXED, __HIP_MEMORY_SCOPE_AGENT); }
__device__ __forceinline__ unsigned xb_add(unsigned* p, unsigned v) { return __hip_atomic_fetch_add(p, v, __ATOMIC_RELAXED, __HIP_MEMORY_SCOPE_AGENT); }
__device__ __forceinline__ unsigned xb_xcc_id() { return (unsigned)__builtin_amdgcn_s_getreg((3 << 11) | 20) & 0xFu; }
#define XB_SPIN(cond, bar) do { unsigned _sp = 0; while (cond) { __builtin_amdgcn_s_sleep(1); \
    if ((++_sp & 255u) == 0u) { if (xb_ld(&(bar)[XB_TMO])) break; if (_sp > XB_SPIN_CAP) { atomicAdd(&(bar)[XB_TMO], 1u); break; } } } } while (0)

struct XcdBarrier {
    unsigned* bar; unsigned x;
    volatile LAS unsigned* st;
};

__device__ __forceinline__ XcdBarrier xcd_barrier_post(unsigned* bar, volatile LAS unsigned* st) {
    XcdBarrier b; b.bar = bar; b.x = xb_xcc_id(); b.st = st;
    if (threadIdx.x == 0) (void)xb_add(&bar[XB_XCNT(b.x)], 1u);
    return b;
}
__device__ __forceinline__ void xcd_barrier_complete(unsigned* bar, unsigned x, unsigned& nloc, unsigned& nx) {
    const unsigned G = gridDim.x * gridDim.y * gridDim.z;
    unsigned sum, cnt, mine, sp = 0u;
    for (;;) {
        sum = 0u; cnt = 0u; mine = 0u;
#pragma unroll
        for (unsigned j = 0; j < 16; ++j) { const unsigned c = xb_ld(&bar[XB_XCNT(j)]); sum += c; cnt += (c > 0u) ? 1u : 0u; mine = (j == x) ? c : mine; }
        if (sum == G) break;
        __builtin_amdgcn_s_sleep(1);
        if ((++sp & 255u) == 0u) { if (xb_ld(&bar[XB_TMO])) break; if (sp > XB_SPIN_CAP) { atomicAdd(&bar[XB_TMO], 1u); break; } }
    }
    nloc = mine > 0u ? mine : 1u; nx = cnt > 0u ? cnt : 1u;
}

__device__ __forceinline__ void xcd_barrier(const XcdBarrier& b) {
    asm volatile("s_waitcnt vmcnt(0)" ::: "memory");
    __syncthreads();
    if (threadIdx.x == 0) {
        unsigned* bar = b.bar;
        __builtin_amdgcn_s_waitcnt(0);
        unsigned nloc = b.st[0], nx = b.st[1];
        if (nloc == 0u) { xcd_barrier_complete(bar, b.x, nloc, nx); b.st[0] = nloc; b.st[1] = nx; }
        const unsigned old = xb_add(&bar[XB_XSUB(b.x)], 1u);
        const unsigned gen = old / nloc;
        if (old + 1u == (gen + 1u) * nloc) {
            __builtin_amdgcn_fence(__ATOMIC_RELEASE, "agent");
            asm volatile("s_waitcnt vmcnt(0)" ::: "memory");
            const unsigned og = xb_add(&bar[XB_TOP], 1u);
            const unsigned tg = og / nx;
            if (og + 1u == (tg + 1u) * nx) xb_add(&bar[XB_TOPGEN], 1u);
            else XB_SPIN(xb_ld(&bar[XB_TOPGEN]) == tg, bar);
            __builtin_amdgcn_fence(__ATOMIC_ACQUIRE, "agent");
            xb_add(&bar[XB_XGEN(b.x)], 1u);
            asm volatile("s_waitcnt vmcnt(0)" ::: "memory");
        } else {
            XB_SPIN(xb_ld(&bar[XB_XGEN(b.x)]) == gen, bar);
            __builtin_amdgcn_fence(__ATOMIC_ACQUIRE, "agent");
            asm volatile("s_waitcnt vmcnt(0)" ::: "memory");
        }
    }
    __syncthreads();
}
#ifdef ASMPK
#define EPK pg8::cvt_pk_bf16
#else
#define EPK pk2
#endif
typedef unsigned v2u __attribute__((ext_vector_type(2)));
typedef float f32x16 __attribute__((ext_vector_type(16)));
typedef short s16x4 __attribute__((ext_vector_type(4)));
__device__ __forceinline__ float bflo(unsigned u) { return __builtin_bit_cast(float, u << 16); }
__device__ __forceinline__ float bfhi(unsigned u) { return __builtin_bit_cast(float, u & 0xffff0000u); }
__device__ __forceinline__ float wave_sum(float v) {
#pragma unroll
    for (int o = 1; o < 64; o <<= 1) v += __shfl_xor(v, o);
    return v;
}

constexpr int NTOK = 16384, SEQ = 8192, DM = 4096, NIN = 10816, NINP = 11008, DFF = 16384, PLE = 256, NWAVES = 8;
constexpr int C_AQ = 0, C_AK = 1024, C_AV = 2048, C_BQ = 3072, C_BK = 4096, C_BV = 5120, C_CQ = 6144, C_CKV = 7168, C_CKR = 7680, C_DQ = 7744, C_DK = 8768, C_DV = 9792;
constexpr float LN_EPS = 1e-5f, RMS_EPS = 1e-6f, DN_ALPHA = 1.41421356237f;
constexpr size_t MiB = 1u << 20;
constexpr size_t WS_CTL = 0, CTL_ZERO_BYTES = 1 * MiB;
constexpr size_t WS_COS128 = 2 * MiB, WS_SIN128 = 4 * MiB, WS_COS64 = 6 * MiB, WS_SIN64 = 7 * MiB;
constexpr size_t WS_RSQ = 8 * MiB, WS_RSKV = 8 * MiB + 65536, WS_LSE = 9 * MiB;
constexpr size_t WS_WIN = 16 * MiB, WS_WO = 102 * MiB, WS_FF1 = 134 * MiB, WS_FF2 = 262 * MiB, WS_GATE = 390 * MiB, WS_PROJ = 422 * MiB, WS_UQ = 424 * MiB, WS_UKV = 427 * MiB;
constexpr size_t WS_XB = 430 * MiB, WS_H = 558 * MiB, WS_DP = 902 * MiB, WS_DO = 998 * MiB, WS_MIX = 1070 * MiB, WS_QM = 1198 * MiB, WS_KVM = 1246 * MiB, WS_Y = 1310 * MiB, WS_PB = 1566 * MiB, WS_END = 1574 * MiB;
constexpr int CW_BAR = 4096, CW_Q = 8192;
constexpr int RING_BYTES = 131072, MISC_OFF = RING_BYTES + 320, LDS_BYTES = 147456;

struct Args { const float* in[20]; float* out; unsigned char* ws; int L, pad; };

template <int ACT  > struct EpiB {
    static constexpr bool PERM = true, AFTER_DRAIN = false;
    bf16* O; int ldc; const float* rowscale;
    __device__ __forceinline__ void operator()(const pg8::f32x4 (&acc)[2][2][4][2], const pg8::Unit& u, int wr, int wc, int fr, int fq) const {
        const int row0 = u.pm * 256 + wr * 64 + fr, col0 = u.pn * 256 + wc * 32 + 8 * fq;
#pragma unroll
        for (int ai = 0; ai < 2; ++ai)
#pragma unroll
            for (int m = 0; m < 4; ++m) { const int row = row0 + ai * 128 + m * 16; bf16* rowp = O + (size_t)row * ldc + col0;
                const float rs = rowscale ? rowscale[row] : 1.f;
#pragma unroll
                for (int bj = 0; bj < 2; ++bj) { pg8::f32x4 v0 = acc[ai][bj][m][0], v1 = acc[ai][bj][m][1];
                    if (ACT == 2) {
#pragma unroll
                        for (int e = 0; e < 4; ++e) { float a = v0[e] > 0.f ? v0[e] : 0.f; v0[e] = a * a; float b = v1[e] > 0.f ? v1[e] : 0.f; v1[e] = b * b; } }
                    v0 = v0 * rs; v1 = v1 * rs;
                    v4u w; w.x = EPK(v0[0], v0[1]); w.y = EPK(v0[2], v0[3]); w.z = EPK(v1[0], v1[1]); w.w = EPK(v1[2], v1[3]);
                    *(v4u*)(rowp + bj * 128) = w; } }
    }
};
template <int GATE  > struct EpiF {
    static constexpr bool PERM = true, AFTER_DRAIN = false;
    float* O; const float* G; int ldc;
    __device__ __forceinline__ void operator()(const pg8::f32x4 (&acc)[2][2][4][2], const pg8::Unit& u, int wr, int wc, int fr, int fq) const {
        const int row0 = u.pm * 256 + wr * 64 + fr, col0 = u.pn * 256 + wc * 32 + 8 * fq;
#pragma unroll
        for (int ai = 0; ai < 2; ++ai)
#pragma unroll
            for (int m = 0; m < 4; ++m) { const size_t off = (size_t)(row0 + ai * 128 + m * 16) * ldc + col0;
#pragma unroll
                for (int bj = 0; bj < 2; ++bj) { pg8::f32x4 v0 = acc[ai][bj][m][0], v1 = acc[ai][bj][m][1];
                    if (GATE) { const pg8::f32x4 g0 = *(const pg8::f32x4*)(G + off + bj * 128), g1 = *(const pg8::f32x4*)(G + off + bj * 128 + 4);
#pragma unroll
                        for (int e = 0; e < 4; ++e) { v0[e] = g0[e] / (1.f + __expf(-v0[e])); v1[e] = g1[e] / (1.f + __expf(-v1[e])); } }
                    *(pg8::f32x4*)(O + off + bj * 128) = v0; *(pg8::f32x4*)(O + off + bj * 128 + 4) = v1; } }
    }
};

struct EpiG {
    static constexpr bool PERM = true, AFTER_DRAIN = false;
    bf16* O; const bf16* G; int ldc;
    __device__ __forceinline__ void operator()(const pg8::f32x4 (&acc)[2][2][4][2], const pg8::Unit& u, int wr, int wc, int fr, int fq) const {
        const int row0 = u.pm * 256 + wr * 64 + fr, col0 = u.pn * 256 + wc * 32 + 8 * fq;
#pragma unroll
        for (int ai = 0; ai < 2; ++ai)
#pragma unroll
            for (int m = 0; m < 4; ++m) { const size_t off = (size_t)(row0 + ai * 128 + m * 16) * ldc + col0;
#pragma unroll
                for (int bj = 0; bj < 2; ++bj) { const pg8::f32x4 v0 = acc[ai][bj][m][0], v1 = acc[ai][bj][m][1]; const v4u g = *(const v4u*)(G + off + bj * 128);
                    float o[8];
#pragma unroll
                    for (int e = 0; e < 4; ++e) { const float a = e < 2 ? v0[2 * e] : v1[2 * e - 4], b = e < 2 ? v0[2 * e + 1] : v1[2 * e - 3];
                        o[2 * e] = bflo(g[e]) / (1.f + __expf(-a)); o[2 * e + 1] = bfhi(g[e]) / (1.f + __expf(-b)); }
                    v4u w; w.x = pk2(o[0], o[1]); w.y = pk2(o[2], o[3]); w.z = pk2(o[4], o[5]); w.w = pk2(o[6], o[7]);
                    *(v4u*)(O + off + bj * 128) = w; } }
    }
};
__device__ __forceinline__ void transpose_item(const float* W, int K, int N, bf16* WT, const float* ks, LAS float* scr, int item, int lane) {
    const int nblk = N / 32, kb = item / nblk, nb = item % nblk, k0 = 64 * kb, n0 = 32 * nb;
    float tv[32];
#pragma unroll
    for (int i = 0; i < 32; ++i) { const int kk = 2 * i + (lane >> 5); tv[i] = W[(size_t)(k0 + kk) * N + n0 + (lane & 31)]; }
#pragma unroll
    for (int i = 0; i < 32; ++i) { const int kk = 2 * i + (lane >> 5); float v = tv[i]; if (ks) v *= ks[k0 + kk]; scr[kk * 33 + (lane & 31)] = v; }
    LDS_WAIT(); asm volatile("" ::: "memory");
    const int c = lane & 7;
#pragma unroll
    for (int j = 0; j < 4; ++j) { const int n = (lane >> 3) + 8 * j; const LAS float* s = scr + (8 * c) * 33 + n;
        v4u o; o.x = pk2(s[0 * 33], s[1 * 33]); o.y = pk2(s[2 * 33], s[3 * 33]); o.z = pk2(s[4 * 33], s[5 * 33]); o.w = pk2(s[6 * 33], s[7 * 33]);
        *(v4u*)(WT + (size_t)(n0 + n) * K + k0 + 8 * c) = o; }
    LDS_WAIT(); asm volatile("" ::: "memory");
}
__device__ __forceinline__ void cvt_rows(const float* src, bf16* dst, size_t n8, size_t gtid, size_t gthreads) {
    for (size_t i = gtid; i < n8; i += gthreads) { const f32x4 a = *(const f32x4*)(src + i * 8), b = *(const f32x4*)(src + i * 8 + 4);
        v4u w; w.x = pk2(a[0], a[1]); w.y = pk2(a[2], a[3]); w.z = pk2(b[0], b[1]); w.w = pk2(b[2], b[3]); *(v4u*)(dst + i * 8) = w; }
}

__device__ __forceinline__ void ln_rows(const float* xs, const bf16* y, const float* g, const float* b, float* xo, bf16* xb, int gw, int ngw, int lane) {
    for (int r = gw; r < NTOK; r += ngw) {
        const f32x4* xr = (const f32x4*)(xs + (size_t)r * DM) + lane; const v2u* yr = (const v2u*)(y + (size_t)r * DM) + lane;
        f32x4 v[16]; float s = 0.f;
#pragma unroll
        for (int j = 0; j < 16; ++j) { const f32x4 a = xr[64 * j]; const v2u cw = yr[64 * j]; const f32x4 c = {bflo(cw.x), bfhi(cw.x), bflo(cw.y), bfhi(cw.y)}; v[j] = a * DN_ALPHA + c; s += (v[j][0] + v[j][1]) + (v[j][2] + v[j][3]); }
        const float mean = wave_sum(s) * (1.f / DM); float s2 = 0.f;
#pragma unroll
        for (int j = 0; j < 16; ++j) { v[j] = v[j] - mean; s2 += (v[j][0] * v[j][0] + v[j][1] * v[j][1]) + (v[j][2] * v[j][2] + v[j][3] * v[j][3]); }
        const float rstd = 1.f / sqrtf(wave_sum(s2) * (1.f / DM) + LN_EPS);
        f32x4* orow = (f32x4*)(xo + (size_t)r * DM) + lane; v2u* brow = (v2u*)(xb + (size_t)r * DM) + lane;
#pragma unroll
        for (int j = 0; j < 16; ++j) { const f32x4 gg = ((const f32x4*)g)[lane + 64 * j], bb = ((const f32x4*)b)[lane + 64 * j]; const f32x4 o = v[j] * rstd * gg + bb;
            orow[64 * j] = o; v2u w; w.x = pk2(o[0], o[1]); w.y = pk2(o[2], o[3]); brow[64 * j] = w; }
    }
}

__device__ __forceinline__ void rope8(bf16* p1, bf16* p2, const float* cs, const float* sn) {
    const v4u a = *(const v4u*)p1, b = *(const v4u*)p2; const f32x4 c0 = *(const f32x4*)cs, c1 = *(const f32x4*)(cs + 4), s0 = *(const f32x4*)sn, s1 = *(const f32x4*)(sn + 4);
    float x1[8], x2[8], c[8], s[8];
#pragma unroll
    for (int e = 0; e < 4; ++e) { x1[2 * e] = bflo(a[e]); x1[2 * e + 1] = bfhi(a[e]); x2[2 * e] = bflo(b[e]); x2[2 * e + 1] = bfhi(b[e]); c[e] = c0[e]; c[e + 4] = c1[e]; s[e] = s0[e]; s[e + 4] = s1[e]; }
    v4u oa, ob;
#pragma unroll
    for (int e = 0; e < 4; ++e) {
        const float y1a = x1[2 * e] * c[2 * e] - x2[2 * e] * s[2 * e], y1b = x1[2 * e + 1] * c[2 * e + 1] - x2[2 * e + 1] * s[2 * e + 1];
        const float y2a = x2[2 * e] * c[2 * e] + x1[2 * e] * s[2 * e], y2b = x2[2 * e + 1] * c[2 * e + 1] + x1[2 * e + 1] * s[2 * e + 1];
        oa[e] = pk2(y1a, y1b); ob[e] = pk2(y2a, y2b); }
    *(v4u*)p1 = oa; *(v4u*)p2 = ob;
}
__device__ __forceinline__ float sumsq8(const bf16* p) { const v4u a = *(const v4u*)p; float s = 0.f;
#pragma unroll
    for (int e = 0; e < 4; ++e) { const float lo = bflo(a[e]), hi = bfhi(a[e]); s += lo * lo + hi * hi; } return s; }
__device__ __forceinline__ void rope_rows(bf16* H, const float* cos128, const float* sin128, const float* cos64, const float* sin64, float* rsq, float* rskv, int gw, int ngw, int lane) {
    for (int r = gw; r < NTOK; r += ngw) {
        bf16* hr = H + (size_t)r * NINP; const int pos = r % SEQ;
        const int j0 = 8 * (lane & 7), hd = lane >> 3;
#pragma unroll
        for (int it = 0; it < 4; ++it) {
            const int head = hd + 8 * it; bf16* base = hr + (head < 16 ? C_BQ + head * 128 : C_DQ + (head - 16) * 128) + j0;
            rope8(base, base + 64, cos128 + (size_t)pos * 64 + j0, sin128 + (size_t)pos * 64 + j0); }
        if (lane < 4) rope8(hr + C_CKR + 8 * lane, hr + C_CKR + 32 + 8 * lane, cos64 + (size_t)pos * 32 + 8 * lane, sin64 + (size_t)pos * 32 + 8 * lane);
        float sq = sumsq8(hr + C_CQ + 8 * lane) + sumsq8(hr + C_CQ + 512 + 8 * lane); float skv = sumsq8(hr + C_CKV + 8 * lane);
        sq = wave_sum(sq); skv = wave_sum(skv);
        if (lane == 0) { rsq[r] = 1.f / sqrtf(sq * (1.f / 1024.f) + RMS_EPS); rskv[r] = 1.f / sqrtf(skv * (1.f / 512.f) + RMS_EPS); }
    }
}

__device__ __forceinline__ void combine_rows(const bf16* DP, const float* LSE, const bf16* DO, const float* lamp, const float* subln, float lam_init, bf16* MIX, int gw, int ngw, int lane) {
    float d0 = lamp[lane] * lamp[128 + lane] + lamp[64 + lane] * lamp[192 + lane], d1 = lamp[256 + lane] * lamp[384 + lane] + lamp[320 + lane] * lamp[448 + lane];
    d0 = wave_sum(d0); d1 = wave_sum(d1);
    const float lam = __expf(d0) - __expf(d1) + lam_init, post = 1.f - lam_init;
    for (int r = gw; r < NTOK; r += ngw) {
#pragma unroll
        for (int i = 0; i < 2; ++i) {
            const int col = 8 * (lane + 64 * i), hd = col >> 7;
            const float l0 = LSE[(size_t)r * 8 + hd], l1 = LSE[(size_t)(NTOK + r) * 8 + hd], l2 = LSE[(size_t)(2 * NTOK + r) * 8 + hd];
            const float mx = fmaxf(l0, fmaxf(l1, l2)); float w0 = __expf(l0 - mx), w1 = __expf(l1 - mx), w2 = __expf(l2 - mx); const float inv = 1.f / (w0 + w1 + w2); w0 *= inv; w1 *= inv; w2 *= inv;
            const v4u a = *(const v4u*)(DP + (size_t)r * 1024 + col), b = *(const v4u*)(DP + ((size_t)NTOK + r) * 1024 + col), c = *(const v4u*)(DP + ((size_t)2 * NTOK + r) * 1024 + col);
            v4u o;
#pragma unroll
            for (int e = 0; e < 4; ++e) o[e] = pk2(w0 * bflo(a[e]) + w1 * bflo(b[e]) + w2 * bflo(c[e]), w0 * bfhi(a[e]) + w1 * bfhi(b[e]) + w2 * bfhi(c[e]));
            *(v4u*)(MIX + (size_t)r * DM + 1024 + col) = o; }
#pragma unroll
        for (int i = 0; i < 2; ++i) {
            const int col = 8 * (lane + 64 * i), dcol = col & 255;
            const v4u a = *(const v4u*)(DO + (size_t)r * 1024 + col), b = *(const v4u*)(DO + ((size_t)NTOK + r) * 1024 + col);
            float v[8]; float ss = 0.f;
#pragma unroll
            for (int e = 0; e < 4; ++e) { v[2 * e] = bflo(a[e]) - lam * bflo(b[e]); v[2 * e + 1] = bfhi(a[e]) - lam * bfhi(b[e]); ss += v[2 * e] * v[2 * e] + v[2 * e + 1] * v[2 * e + 1]; }
#pragma unroll
            for (int o = 1; o < 32; o <<= 1) ss += __shfl_xor(ss, o);
            const float rs = post / sqrtf(ss * (1.f / 256.f) + RMS_EPS);
            const f32x4 g0 = *(const f32x4*)(subln + dcol), g1 = *(const f32x4*)(subln + dcol + 4);
            v4u o; o.x = pk2(v[0] * rs * g0[0], v[1] * rs * g0[1]); o.y = pk2(v[2] * rs * g0[2], v[3] * rs * g0[3]); o.z = pk2(v[4] * rs * g1[0], v[5] * rs * g1[1]); o.w = pk2(v[6] * rs * g1[2], v[7] * rs * g1[3]);
            *(v4u*)(MIX + (size_t)r * DM + 3072 + col) = o; }
    }
}
struct AttnDesc {
    const bf16* Q; const bf16* K; const bf16* K2; const bf16* V; bf16* O; float* LSE; const float* cosT; const float* sinT;
    int ldq, ldk, ldk2, ldv, ldo, lse_ld;
    int row0, rstride, iq0, W, pos0; float scale;
};
#define MFMA32(a, b, c) __builtin_amdgcn_mfma_f32_32x32x16_bf16((a), (b), (c), 0, 0, 0)
__device__ __forceinline__ bf16x8 pack8(const f32x16& x, int s) {
    v4u p; p.x = pk2(x[8 * s], x[8 * s + 1]); p.y = pk2(x[8 * s + 2], x[8 * s + 3]); p.z = pk2(x[8 * s + 4], x[8 * s + 5]); p.w = pk2(x[8 * s + 6], x[8 * s + 7]);
    return __builtin_bit_cast(bf16x8, p);
}
constexpr float LOG2E = 1.44269504089f, LN2 = 0.69314718056f;

template <int DK, int MODE  , bool ROPEQ>
__device__ __forceinline__ void attn_unit(LAS unsigned char* lds, const AttnDesc& d, int tid, int wid, int lane) {
    constexpr int NKC = DK / 16, KS = DK * 2 + 16, VS = 136, NKP = DK / 64, KCH = DK / 8;
    const int n = lane & 31, h = lane >> 5;
    const int iq = d.iq0 + 32 * wid + n;
    const size_t qtok = (size_t)d.row0 + (size_t)iq * d.rstride;
    bf16x8 qf[NKC];
    { const bf16* qrow = d.Q + qtok * d.ldq;
#pragma unroll
      for (int c = 0; c < NKC; ++c) qf[c] = *(const bf16x8*)(qrow + 16 * c + 8 * h); }
    if constexpr (ROPEQ) {
        const int pos = d.pos0 + iq * d.rstride;
#pragma unroll
        for (int cc = 0; cc < 2; ++cc) { const int j0 = 16 * cc + 8 * h; const float* cp = d.cosT + (size_t)pos * 32 + j0; const float* sp = d.sinT + (size_t)pos * 32 + j0;
            const v4u a = __builtin_bit_cast(v4u, qf[8 + cc]), b = __builtin_bit_cast(v4u, qf[10 + cc]); v4u oa, ob;
#pragma unroll
            for (int e = 0; e < 4; ++e) { const float c0 = cp[2 * e], c1 = cp[2 * e + 1], s0 = sp[2 * e], s1 = sp[2 * e + 1];
                const float x1a = bflo(a[e]), x1b = bfhi(a[e]), x2a = bflo(b[e]), x2b = bfhi(b[e]);
                oa[e] = pk2(x1a * c0 - x2a * s0, x1b * c1 - x2b * s1); ob[e] = pk2(x2a * c0 + x1a * s0, x2b * c1 + x1b * s1); }
            qf[8 + cc] = __builtin_bit_cast(bf16x8, oa); qf[10 + cc] = __builtin_bit_cast(bf16x8, ob); }
    }
    const int jhi = d.iq0 / 64 + 3; int lo_key = d.iq0 - d.W; if (lo_key < 0) lo_key = 0; const int jlo = lo_key / 64;
    const int wq_min = d.iq0 + 32 * wid, wq_max = wq_min + 31;
    f32x16 o[4];
#pragma unroll
    for (int s = 0; s < 4; ++s)
#pragma unroll
        for (int e = 0; e < 16; ++e) o[s][e] = 0.f;
    float m_run = -INFINITY, l_run = 0.f, carry = 0.f;
    const float sc2 = d.scale * LOG2E;
    v4u kreg[NKP], vreg[2];
    const int vkey = tid & 63, vch0 = tid >> 6;
#define ATT_PREFETCH(j) do { \
        _Pragma("unroll") for (int i = 0; i < NKP; ++i) { const int p = tid + 512 * i, key = p / KCH, ch = p % KCH; const size_t tok = (size_t)d.row0 + (size_t)(64 * (j) + key) * d.rstride; \
            const bf16* src = (DK == 192 && ch >= 16) ? d.K2 + tok * d.ldk2 + (ch - 16) * 8 : d.K + tok * d.ldk + ch * 8; kreg[i] = *(const v4u*)src; } \
        { const size_t tok = (size_t)d.row0 + (size_t)(64 * (j) + vkey) * d.rstride; const bf16* src = d.V + tok * d.ldv; \
          vreg[0] = *(const v4u*)(src + vch0 * 8); vreg[1] = *(const v4u*)(src + (vch0 + 8) * 8); } } while (0)
#define ATT_WRITE(BUFOFF) do { LAS unsigned char* wK = lds + (BUFOFF); LAS unsigned char* wV = wK + 64 * KS; \
        _Pragma("unroll") for (int i = 0; i < NKP; ++i) { const int p = tid + 512 * i, key = p / KCH, ch = p % KCH; *(LAS v4u*)(wK + key * KS + ch * 16) = kreg[i]; } \
        _Pragma("unroll") for (int i = 0; i < 2; ++i) { const int dv0 = (vch0 + 8 * i) * 8; \
            _Pragma("unroll") for (int e = 0; e < 4; ++e) { *(LAS unsigned short*)(wV + (dv0 + 2 * e) * VS + vkey * 2) = (unsigned short)(vreg[i][e] & 0xffffu); *(LAS unsigned short*)(wV + (dv0 + 2 * e + 1) * VS + vkey * 2) = (unsigned short)(vreg[i][e] >> 16); } } } while (0)
#define ATT_COMPUTE(BUFOFF) do { LAS unsigned char* ldsK = lds + (BUFOFF); LAS unsigned char* ldsV = ldsK + 64 * KS; const int k0 = 64 * j; \
        if (!(k0 > wq_max || (wq_min - (k0 + 63)) > d.W)) { \
        f32x16 s0, s1; \
_Pragma("unroll") \
        for (int e = 0; e < 16; ++e) { s0[e] = 0.f; s1[e] = 0.f; } \
        __builtin_amdgcn_s_setprio(1); \
_Pragma("unroll") \
        for (int c = 0; c < NKC; ++c) { \
            const bf16x8 a0 = *(const LAS bf16x8*)(ldsK + n * KS + c * 32 + h * 16), a1 = *(const LAS bf16x8*)(ldsK + (32 + n) * KS + c * 32 + h * 16); \
            s0 = MFMA32(a0, qf[c], s0); s1 = MFMA32(a1, qf[c], s1); } \
        __builtin_amdgcn_s_setprio(0); \
        const bool full = (k0 + 63 <= wq_min - MODE) && (wq_max - k0 <= d.W); \
        if constexpr (MODE == 0) { \
            if (!full) { \
_Pragma("unroll") \
                for (int e = 0; e < 16; ++e) { const int ik = k0 + (e & 3) + 8 * (e >> 2) + 4 * h; const int dd0 = iq - ik, dd1 = dd0 - 32; \
                    if (dd0 < 0 || dd0 > d.W) s0[e] = -INFINITY; if (dd1 < 0 || dd1 > d.W) s1[e] = -INFINITY; } } \
            float mx = fmaxf(s0[0], s1[0]); \
_Pragma("unroll") \
            for (int e = 1; e < 16; ++e) mx = fmaxf(mx, fmaxf(s0[e], s1[e])); \
            mx = fmaxf(mx, __shfl_xor(mx, 32)); \
            const float m_new = fmaxf(m_run, mx); \
            const float msafe = (m_new == -INFINITY) ? 0.f : m_new; \
            const float mb = msafe * sc2; \
            const float alpha = __builtin_amdgcn_exp2f((m_run - msafe) * sc2); \
            float rs = 0.f; \
_Pragma("unroll") \
            for (int e = 0; e < 16; ++e) { s0[e] = __builtin_amdgcn_exp2f(__builtin_fmaf(s0[e], sc2, -mb)); s1[e] = __builtin_amdgcn_exp2f(__builtin_fmaf(s1[e], sc2, -mb)); rs += s0[e] + s1[e]; } \
            l_run = l_run * alpha + rs; m_run = m_new; \
            if (__builtin_amdgcn_ballot_w64(alpha != 1.f) != 0ull) { \
_Pragma("unroll") \
                for (int s = 0; s < 4; ++s) \
_Pragma("unroll") \
                    for (int e = 0; e < 16; ++e) o[s][e] *= alpha; } \
        } else { \
            const float sc = d.scale; \
_Pragma("unroll") \
            for (int t = 1; t >= 0; --t) { \
                f32x16& S = t ? s1 : s0; float l1m[16]; float g[4], pg[4]; \
_Pragma("unroll") \
                for (int e = 0; e < 16; ++e) { const int ik = k0 + 32 * t + (e & 3) + 8 * (e >> 2) + 4 * h; const bool valid = full || (ik < iq); \
                    const float z = S[e] * sc2; const float lp = __builtin_amdgcn_logf(1.f + __builtin_amdgcn_exp2f(-fabsf(z))); \
                    const float lb = fminf(z, 0.f) - lp; \
                    l1m[e] = valid ? (lb - z) : 0.f; \
                    S[e] = valid ? lb : -INFINITY; } \
_Pragma("unroll") \
                for (int i = 0; i < 4; ++i) { g[i] = (l1m[4 * i] + l1m[4 * i + 1]) + (l1m[4 * i + 2] + l1m[4 * i + 3]); pg[i] = __shfl_xor(g[i], 32); } \
                float run = carry; \
_Pragma("unroll") \
                for (int i = 3; i >= 0; --i) { float acc = run + (h == 0 ? pg[i] : 0.f); \
_Pragma("unroll") \
                    for (int jj = 3; jj >= 0; --jj) { const int e = 4 * i + jj; S[e] = __builtin_amdgcn_exp2f(S[e] + acc); acc += l1m[e]; } \
                    run += g[i] + pg[i]; } \
                carry = run; \
            } \
        } \
        bf16x8 pf[2][2]; \
        pf[0][0] = pack8(s0, 0); pf[0][1] = pack8(s0, 1); pf[1][0] = pack8(s1, 0); pf[1][1] = pack8(s1, 1); \
        __builtin_amdgcn_s_setprio(1); \
_Pragma("unroll") \
        for (int s = 0; s < 4; ++s) \
_Pragma("unroll") \
            for (int t = 0; t < 2; ++t) \
_Pragma("unroll") \
                for (int c = 0; c < 2; ++c) { const LAS unsigned char* vp = ldsV + (32 * s + n) * VS + (32 * t + 16 * c + 4 * h) * 2; \
                    const s16x4 v0 = *(const LAS s16x4*)vp, v1 = *(const LAS s16x4*)(vp + 16); \
                    const bf16x8 vf = __builtin_shufflevector(v0, v1, 0, 1, 2, 3, 4, 5, 6, 7); \
                    o[s] = MFMA32(vf, pf[t][c], o[s]); } \
        __builtin_amdgcn_s_setprio(0); \
        } } while (0)
    ATT_PREFETCH(jhi); ATT_WRITE(0); __syncthreads();
    for (int j = jhi;;) {
        if (j > jlo) ATT_PREFETCH(j - 1);
        ATT_COMPUTE(0);
        if (j > jlo) ATT_WRITE(49152);
        __syncthreads();
        if (j == jlo) break; --j;
        if (j > jlo) ATT_PREFETCH(j - 1);
        ATT_COMPUTE(49152);
        if (j > jlo) ATT_WRITE(0);
        __syncthreads();
        if (j == jlo) break; --j;
    }
#undef ATT_PREFETCH
#undef ATT_WRITE
#undef ATT_COMPUTE
    float inv = 1.f;
    if constexpr (MODE == 0) { const float l = l_run + __shfl_xor(l_run, 32); inv = 1.f / l;
        if (d.LSE && h == 0) d.LSE[qtok * d.lse_ld] = (m_run * sc2 + __builtin_amdgcn_logf(l)) * LN2; }
    bf16* orow = d.O + qtok * d.ldo;
#pragma unroll
    for (int s = 0; s < 4; ++s)
#pragma unroll
        for (int i = 0; i < 4; ++i) { v2u w; w.x = pk2(o[s][4 * i] * inv, o[s][4 * i + 1] * inv); w.y = pk2(o[s][4 * i + 2] * inv, o[s][4 * i + 3] * inv);
            *(v2u*)(orow + 32 * s + 8 * i + 4 * h) = w; }
}

#define PHL unsigned char* wsl = args.ws; asm volatile("" : "+s"(wsl)); int tid = threadIdx.x; asm volatile("" : "+v"(tid)); const int lane = tid & 63, wave = __builtin_amdgcn_readfirstlane(tid >> 6); const int G = gridDim.x, gw = blockIdx.x * NWAVES + wave, ngw = G * NWAVES; (void)lane; (void)gw; (void)ngw; (void)G
#define WP(T, off) ((T*)(wsl + (off)))
#define PH_ON(k) if constexpr (PH < 0 || PH == (k))
#define GRIDBAR() do { if constexpr (PH < 0) xcd_barrier(bar); } while (0)
#define QFETCH(q, CNT) \
                __syncthreads(); \
                if (tid == 0) { int x = (int)uq[1], tries = (int)uq[2]; int v = -1; \
                    while (tries < 8) { v = (int)__hip_atomic_fetch_add(ctl + CW_Q + 64 * ((L * 4 + (q)) * 8 + x), 1u, RLX_AGENT); if (v < (CNT)) break; v = -1; x = (x + 1) & 7; ++tries; } \
                    uq[0] = (unsigned)v; uq[1] = (unsigned)x; uq[2] = (unsigned)tries; } \
                __syncthreads(); \
                const int qv = (int)uq[0], qx = (int)uq[1]; if (qv < 0) break;
#define QINIT() do { __syncthreads(); if (tid == 0) { uq[1] = xb_xcc_id() & 7u; uq[2] = 0u; } } while (0)
#define ONE_LAUNCH 1
#if ONE_LAUNCH
__global__ void __launch_bounds__(512, 2) hybrid_one(Args args) {

    extern __shared__ __attribute__((aligned(16))) unsigned char lds_raw[];
    LAS unsigned char* lds = (LAS unsigned char*)lds_raw;
    volatile LAS unsigned* MISC = (volatile LAS unsigned*)(lds + MISC_OFF);
    for (int u = threadIdx.x; u < (LDS_BYTES - RING_BYTES) / 4; u += 512) ((LAS unsigned*)(lds + RING_BYTES))[u] = 0u;
    __syncthreads();

    XcdBarrier bar = xcd_barrier_post((unsigned*)((gu32*)(args.ws + WS_CTL) + CW_BAR), MISC + 8);
    { constexpr int L = 0; constexpr int PH = -1;

        PH_ON(0) {
            PHL; const size_t gtid = (size_t)blockIdx.x * 512 + tid, gthreads = (size_t)G * 512;
            LAS float* scr = (LAS float*)(lds + wave * 16384);
            constexpr int I_IN = 64 * (NIN / 32), I_O = 64 * 128, I_UQ = 16 * 48, I_UKV = 8 * 64, I_F1 = 64 * 512, I_F2 = 256 * 128, I_G = 64 * 128, I_P = 4 * 128;
            constexpr int NITEMS = I_IN + I_O + I_UQ + I_UKV + I_F1 + I_F2 + I_G + I_P;
            for (int it = gw; it < NITEMS; it += ngw) {
                int r = it;
                if (r < I_IN) { transpose_item(args.in[2] + (size_t)L * DM * NIN, DM, NIN, WP(bf16, WS_WIN), nullptr, scr, r, lane); continue; } r -= I_IN;
                if (r < I_O) { transpose_item(args.in[3] + (size_t)L * DM * DM, DM, DM, WP(bf16, WS_WO), nullptr, scr, r, lane); continue; } r -= I_O;
                if (r < I_UQ) { transpose_item(args.in[5] + (size_t)L * 1024 * 1536, 1024, 1536, WP(bf16, WS_UQ), args.in[4] + (size_t)L * 1024, scr, r, lane); continue; } r -= I_UQ;
                if (r < I_UKV) { transpose_item(args.in[7] + (size_t)L * 512 * 2048, 512, 2048, WP(bf16, WS_UKV), args.in[6] + (size_t)L * 512, scr, r, lane); continue; } r -= I_UKV;
                if (r < I_F1) { transpose_item(args.in[12] + (size_t)L * DM * DFF, DM, DFF, WP(bf16, WS_FF1), nullptr, scr, r, lane); continue; } r -= I_F1;
                if (r < I_F2) { transpose_item(args.in[13] + (size_t)L * DFF * DM, DFF, DM, WP(bf16, WS_FF2), nullptr, scr, r, lane); continue; } r -= I_F2;
                if (r < I_G) { transpose_item(args.in[16] + (size_t)L * DM * DM, DM, DM, WP(bf16, WS_GATE), nullptr, scr, r, lane); continue; } r -= I_G;
                transpose_item(args.in[17] + (size_t)L * PLE * DM, PLE, DM, WP(bf16, WS_PROJ), nullptr, scr, r, lane);
            }
            { v4u z = {0u, 0u, 0u, 0u}; v4u* pad = (v4u*)(WP(bf16, WS_WIN) + (size_t)NIN * DM); const size_t n16 = (size_t)(NINP - NIN) * DM / 8; for (size_t i = gtid; i < n16; i += gthreads) pad[i] = z; }
            cvt_rows(args.in[1] + (size_t)L * NTOK * PLE, WP(bf16, WS_PB), (size_t)NTOK * PLE / 8, gtid, gthreads);
            if (L == 0) {
                cvt_rows(args.in[0], WP(bf16, WS_XB), (size_t)NTOK * DM / 8, gtid, gthreads);
                float* cos128 = WP(float, WS_COS128); float* sin128 = WP(float, WS_SIN128); float* cos64 = WP(float, WS_COS64); float* sin64 = WP(float, WS_SIN64);
                for (size_t i = gtid; i < (size_t)SEQ * 64; i += gthreads) { const int pos = (int)(i >> 6), j = (int)(i & 63); const float inv = powf(10000.0f, -(float)j / 64.0f); const float ang = (float)pos * inv; cos128[i] = cosf(ang); sin128[i] = sinf(ang); }
                for (size_t i = gtid; i < (size_t)SEQ * 32; i += gthreads) { const int pos = (int)(i >> 5), j = (int)(i & 31); const float inv = powf(10000.0f, -(float)j / 32.0f); const float ang = (float)pos * inv; cos64[i] = cosf(ang); sin64[i] = sinf(ang); }
            }
        }
        GRIDBAR();
        PH_ON(1) { PHL; pg8::Gemm g{WP(bf16, WS_XB), WP(bf16, WS_WIN), NTOK, NINP, DM, DM}; pg8::StaticOrder S; S.init(NTOK, NINP, G, (int)blockIdx.x); EpiB<0> E{WP(bf16, WS_H), NINP, nullptr};
          pg8::gemm_phase<EpiB<0>, pg8::StaticOrder, true, true>(lds, g, S, E); }
        GRIDBAR();
        PH_ON(2) { PHL; rope_rows(WP(bf16, WS_H), WP(float, WS_COS128), WP(float, WS_SIN128), WP(float, WS_COS64), WP(float, WS_SIN64), WP(float, WS_RSQ), WP(float, WS_RSKV), gw, ngw, lane); }
        GRIDBAR();
        PH_ON(3) {
        { PHL; pg8::Gemm g{WP(bf16, WS_H) + C_CQ, WP(bf16, WS_UQ), NTOK, 1536, 1024, NINP}; pg8::StaticOrder S; S.init(NTOK, 1536, G, (int)blockIdx.x); EpiB<0> E{WP(bf16, WS_QM), 1536, WP(float, WS_RSQ)};
          pg8::gemm_phase<EpiB<0>, pg8::StaticOrder, true, true>(lds, g, S, E); }
        __syncthreads();
        { PHL; pg8::Gemm g{WP(bf16, WS_H) + C_CKV, WP(bf16, WS_UKV), NTOK, 2048, 512, NINP}; pg8::StaticOrder S; S.init(NTOK, 2048, G, (int)blockIdx.x); EpiB<0> E{WP(bf16, WS_KVM), 2048, WP(float, WS_RSKV)};
          pg8::gemm_phase<EpiB<0>, pg8::StaticOrder, true, true>(lds, g, S, E); }
        }
        GRIDBAR();
        PH_ON(4) {
            LAS unsigned* uq = (LAS unsigned*)(lds + MISC_OFF + 64);
            { PHL; gu32* ctl = WP(gu32, WS_CTL); bf16* H = WP(bf16, WS_H); bf16* MIX = WP(bf16, WS_MIX);
            QINIT();
            for (;;) {
                QFETCH(0, 64);
                const int qb = 31 - (qv >> 1), bh = 2 * qx + (qv & 1), b = bh / 8, hd = bh % 8;
                AttnDesc d; d.Q = H + C_AQ + hd * 128; d.K = H + C_AK + hd * 128; d.K2 = nullptr; d.V = H + C_AV + hd * 128; d.O = MIX + hd * 128; d.LSE = nullptr; d.cosT = nullptr; d.sinT = nullptr;
                d.ldq = NINP; d.ldk = NINP; d.ldk2 = 0; d.ldv = NINP; d.ldo = DM; d.lse_ld = 0; d.row0 = b * SEQ; d.rstride = 1; d.iq0 = qb * 256; d.W = 1 << 29; d.pos0 = 0; d.scale = 0.08838834764831845f;
                attn_unit<128, 1, false>(lds, d, tid, wave, lane);
            } }
            { PHL; gu32* ctl = WP(gu32, WS_CTL); bf16* QM = WP(bf16, WS_QM); bf16* KVM = WP(bf16, WS_KVM);
            QINIT();
            for (;;) {
                QFETCH(1, 64);
                const int qb = 31 - (qv >> 1), bh = 2 * qx + (qv & 1), b = bh / 8, hd = bh % 8;
                AttnDesc d; d.Q = QM + hd * 192; d.K = KVM + hd * 256; d.K2 = WP(bf16, WS_H) + C_CKR; d.V = KVM + hd * 256 + 128; d.O = WP(bf16, WS_MIX) + 2048 + hd * 128; d.LSE = nullptr; d.cosT = WP(float, WS_COS64); d.sinT = WP(float, WS_SIN64);
                d.ldq = 1536; d.ldk = 2048; d.ldk2 = NINP; d.ldv = 2048; d.ldo = DM; d.lse_ld = 0; d.row0 = b * SEQ; d.rstride = 1; d.iq0 = qb * 256; d.W = 1 << 29; d.pos0 = 0; d.scale = 0.07216878364870323f;
                attn_unit<192, 0, true>(lds, d, tid, wave, lane);
            } }
            { PHL; gu32* ctl = WP(gu32, WS_CTL); bf16* H = WP(bf16, WS_H);
            QINIT();
            for (;;) {
                QFETCH(2, 320);
                AttnDesc d; d.K2 = nullptr; d.cosT = nullptr; d.sinT = nullptr; d.ldq = NINP; d.ldk = NINP; d.ldk2 = 0; d.ldv = NINP; d.ldo = 1024; d.pos0 = 0; d.scale = 0.08838834764831845f;
                if (qv < 128) {
                    const int qb = 31 - (qv >> 2), v = 4 * qx + (qv & 3), b = v / 16, vh = v % 16, hd = vh / 4, map = (vh / 2) % 2, half = vh % 2;
                    d.Q = H + C_DQ + hd * 256 + map * 128; d.K = H + C_DK + hd * 256 + map * 128; d.V = H + C_DV + hd * 256 + half * 128; d.O = WP(bf16, WS_DO) + (size_t)map * NTOK * 1024 + hd * 256 + half * 128; d.LSE = nullptr; d.lse_ld = 0;
                    d.row0 = b * SEQ; d.rstride = 1; d.iq0 = qb * 256; d.W = 1 << 29;
                } else {
                    const int w = qv - 128, pr = 2 * qx + w / 96, b = pr / 8, hd = pr % 8, r2 = w % 96, br = r2 / 32, idx = r2 % 32;
                    const int dil = br == 0 ? 1 : (br == 1 ? 4 : 16), nqb = 32 / dil, res = idx / nqb, qb = idx % nqb;
                    d.Q = H + C_BQ + hd * 128; d.K = H + C_BK + hd * 128; d.V = H + C_BV + hd * 128; d.O = WP(bf16, WS_DP) + (size_t)br * NTOK * 1024 + hd * 128; d.LSE = WP(float, WS_LSE) + (size_t)br * NTOK * 8 + hd; d.lse_ld = 8;
                    d.row0 = b * SEQ + res; d.rstride = dil; d.iq0 = qb * 256; d.W = 128;
                }
                attn_unit<128, 0, false>(lds, d, tid, wave, lane);
            } }
        }
        GRIDBAR();
        PH_ON(5) { PHL; const float lam_init = (L == 0) ? 0.2f : 0.35550906f;
          combine_rows(WP(bf16, WS_DP), WP(float, WS_LSE), WP(bf16, WS_DO), args.in[8] + (size_t)L * 512, args.in[9] + (size_t)L * 256, lam_init, WP(bf16, WS_MIX), gw, ngw, lane); }
        GRIDBAR();
        PH_ON(6) { PHL; pg8::Gemm g{WP(bf16, WS_MIX), WP(bf16, WS_WO), NTOK, DM, DM, DM}; pg8::StaticOrder S; S.init(NTOK, DM, G, (int)blockIdx.x); EpiB<0> E{WP(bf16, WS_Y), DM, nullptr};
          pg8::gemm_phase<EpiB<0>, pg8::StaticOrder, true, true>(lds, g, S, E); }
        GRIDBAR();
        PH_ON(7) { PHL; ln_rows(L == 0 ? args.in[0] : args.out, WP(bf16, WS_Y), args.in[10] + (size_t)L * DM, args.in[11] + (size_t)L * DM, args.out, WP(bf16, WS_XB), gw, ngw, lane); }
        GRIDBAR();
        PH_ON(8) { PHL; pg8::Gemm g{WP(bf16, WS_XB), WP(bf16, WS_FF1), NTOK, DFF, DM, DM}; pg8::StaticOrder S; S.init(NTOK, DFF, G, (int)blockIdx.x); EpiB<2> E{WP(bf16, WS_H), DFF, nullptr};
          pg8::gemm_phase<EpiB<2>, pg8::StaticOrder, true, true>(lds, g, S, E); }
        GRIDBAR();
        PH_ON(9) { PHL; pg8::Gemm g{WP(bf16, WS_H), WP(bf16, WS_FF2), NTOK, DM, DFF, DFF}; pg8::StaticOrder S; S.init(NTOK, DM, G, (int)blockIdx.x); EpiB<0> E{WP(bf16, WS_Y), DM, nullptr};
          pg8::gemm_phase<EpiB<0>, pg8::StaticOrder, true, true>(lds, g, S, E); }
        GRIDBAR();
        PH_ON(10) {
        { PHL; ln_rows(args.out, WP(bf16, WS_Y), args.in[14] + (size_t)L * DM, args.in[15] + (size_t)L * DM, args.out, WP(bf16, WS_XB), gw, ngw, lane); }
        __syncthreads();
        { PHL; pg8::Gemm g{WP(bf16, WS_PB), WP(bf16, WS_PROJ), NTOK, DM, PLE, PLE}; pg8::StaticOrder S; S.init(NTOK, DM, G, (int)blockIdx.x); EpiB<0> E{WP(bf16, WS_H), DM, nullptr};
          pg8::gemm_phase<EpiB<0>, pg8::StaticOrder, true, true>(lds, g, S, E); }
        }
        GRIDBAR();
        PH_ON(11) { PHL; pg8::Gemm g{WP(bf16, WS_XB), WP(bf16, WS_GATE), NTOK, DM, DM, DM}; pg8::StaticOrder S; S.init(NTOK, DM, G, (int)blockIdx.x); EpiG E{WP(bf16, WS_Y), WP(bf16, WS_H), DM};
          pg8::gemm_phase<EpiG, pg8::StaticOrder, true, true>(lds, g, S, E); }
        GRIDBAR();
        PH_ON(12) { PHL; ln_rows(args.out, WP(bf16, WS_Y), args.in[18] + (size_t)L * DM, args.in[19] + (size_t)L * DM, args.out, WP(bf16, WS_XB), gw, ngw, lane); }

        xcd_barrier(bar);
    }
    { constexpr int L = 1; constexpr int PH = -1;

        PH_ON(0) {
            PHL; const size_t gtid = (size_t)blockIdx.x * 512 + tid, gthreads = (size_t)G * 512;
            LAS float* scr = (LAS float*)(lds + wave * 16384);
            constexpr int I_IN = 64 * (NIN / 32), I_O = 64 * 128, I_UQ = 16 * 48, I_UKV = 8 * 64, I_F1 = 64 * 512, I_F2 = 256 * 128, I_G = 64 * 128, I_P = 4 * 128;
            constexpr int NITEMS = I_IN + I_O + I_UQ + I_UKV + I_F1 + I_F2 + I_G + I_P;
            for (int it = gw; it < NITEMS; it += ngw) {
                int r = it;
                if (r < I_IN) { transpose_item(args.in[2] + (size_t)L * DM * NIN, DM, NIN, WP(bf16, WS_WIN), nullptr, scr, r, lane); continue; } r -= I_IN;
                if (r < I_O) { transpose_item(args.in[3] + (size_t)L * DM * DM, DM, DM, WP(bf16, WS_WO), nullptr, scr, r, lane); continue; } r -= I_O;
                if (r < I_UQ) { transpose_item(args.in[5] + (size_t)L * 1024 * 1536, 1024, 1536, WP(bf16, WS_UQ), args.in[4] + (size_t)L * 1024, scr, r, lane); continue; } r -= I_UQ;
                if (r < I_UKV) { transpose_item(args.in[7] + (size_t)L * 512 * 2048, 512, 2048, WP(bf16, WS_UKV), args.in[6] + (size_t)L * 512, scr, r, lane); continue; } r -= I_UKV;
                if (r < I_F1) { transpose_item(args.in[12] + (size_t)L * DM * DFF, DM, DFF, WP(bf16, WS_FF1), nullptr, scr, r, lane); continue; } r -= I_F1;
                if (r < I_F2) { transpose_item(args.in[13] + (size_t)L * DFF * DM, DFF, DM, WP(bf16, WS_FF2), nullptr, scr, r, lane); continue; } r -= I_F2;
                if (r < I_G) { transpose_item(args.in[16] + (size_t)L * DM * DM, DM, DM, WP(bf16, WS_GATE), nullptr, scr, r, lane); continue; } r -= I_G;
                transpose_item(args.in[17] + (size_t)L * PLE * DM, PLE, DM, WP(bf16, WS_PROJ), nullptr, scr, r, lane);
            }
            { v4u z = {0u, 0u, 0u, 0u}; v4u* pad = (v4u*)(WP(bf16, WS_WIN) + (size_t)NIN * DM); const size_t n16 = (size_t)(NINP - NIN) * DM / 8; for (size_t i = gtid; i < n16; i += gthreads) pad[i] = z; }
            cvt_rows(args.in[1] + (size_t)L * NTOK * PLE, WP(bf16, WS_PB), (size_t)NTOK * PLE / 8, gtid, gthreads);
            if (L == 0) {
                cvt_rows(args.in[0], WP(bf16, WS_XB), (size_t)NTOK * DM / 8, gtid, gthreads);
                float* cos128 = WP(float, WS_COS128); float* sin128 = WP(float, WS_SIN128); float* cos64 = WP(float, WS_COS64); float* sin64 = WP(float, WS_SIN64);
                for (size_t i = gtid; i < (size_t)SEQ * 64; i += gthreads) { const int pos = (int)(i >> 6), j = (int)(i & 63); const float inv = powf(10000.0f, -(float)j / 64.0f); const float ang = (float)pos * inv; cos128[i] = cosf(ang); sin128[i] = sinf(ang); }
                for (size_t i = gtid; i < (size_t)SEQ * 32; i += gthreads) { const int pos = (int)(i >> 5), j = (int)(i & 31); const float inv = powf(10000.0f, -(float)j / 32.0f); const float ang = (float)pos * inv; cos64[i] = cosf(ang); sin64[i] = sinf(ang); }
            }
        }
        GRIDBAR();
        PH_ON(1) { PHL; pg8::Gemm g{WP(bf16, WS_XB), WP(bf16, WS_WIN), NTOK, NINP, DM, DM}; pg8::StaticOrder S; S.init(NTOK, NINP, G, (int)blockIdx.x); EpiB<0> E{WP(bf16, WS_H), NINP, nullptr};
          pg8::gemm_phase<EpiB<0>, pg8::StaticOrder, true, true>(lds, g, S, E); }
        GRIDBAR();
        PH_ON(2) { PHL; rope_rows(WP(bf16, WS_H), WP(float, WS_COS128), WP(float, WS_SIN128), WP(float, WS_COS64), WP(float, WS_SIN64), WP(float, WS_RSQ), WP(float, WS_RSKV), gw, ngw, lane); }
        GRIDBAR();
        PH_ON(3) {
        { PHL; pg8::Gemm g{WP(bf16, WS_H) + C_CQ, WP(bf16, WS_UQ), NTOK, 1536, 1024, NINP}; pg8::StaticOrder S; S.init(NTOK, 1536, G, (int)blockIdx.x); EpiB<0> E{WP(bf16, WS_QM), 1536, WP(float, WS_RSQ)};
          pg8::gemm_phase<EpiB<0>, pg8::StaticOrder, true, true>(lds, g, S, E); }
        __syncthreads();
        { PHL; pg8::Gemm g{WP(bf16, WS_H) + C_CKV, WP(bf16, WS_UKV), NTOK, 2048, 512, NINP}; pg8::StaticOrder S; S.init(NTOK, 2048, G, (int)blockIdx.x); EpiB<0> E{WP(bf16, WS_KVM), 2048, WP(float, WS_RSKV)};
          pg8::gemm_phase<EpiB<0>, pg8::StaticOrder, true, true>(lds, g, S, E); }
        }
        GRIDBAR();
        PH_ON(4) {
            LAS unsigned* uq = (LAS unsigned*)(lds + MISC_OFF + 64);
            { PHL; gu32* ctl = WP(gu32, WS_CTL); bf16* H = WP(bf16, WS_H); bf16* MIX = WP(bf16, WS_MIX);
            QINIT();
            for (;;) {
                QFETCH(0, 64);
                const int qb = 31 - (qv >> 1), bh = 2 * qx + (qv & 1), b = bh / 8, hd = bh % 8;
                AttnDesc d; d.Q = H + C_AQ + hd * 128; d.K = H + C_AK + hd * 128; d.K2 = nullptr; d.V = H + C_AV + hd * 128; d.O = MIX + hd * 128; d.LSE = nullptr; d.cosT = nullptr; d.sinT = nullptr;
                d.ldq = NINP; d.ldk = NINP; d.ldk2 = 0; d.ldv = NINP; d.ldo = DM; d.lse_ld = 0; d.row0 = b * SEQ; d.rstride = 1; d.iq0 = qb * 256; d.W = 1 << 29; d.pos0 = 0; d.scale = 0.08838834764831845f;
                attn_unit<128, 1, false>(lds, d, tid, wave, lane);
            } }
            { PHL; gu32* ctl = WP(gu32, WS_CTL); bf16* QM = WP(bf16, WS_QM); bf16* KVM = WP(bf16, WS_KVM);
            QINIT();
            for (;;) {
                QFETCH(1, 64);
                const int qb = 31 - (qv >> 1), bh = 2 * qx + (qv & 1), b = bh / 8, hd = bh % 8;
                AttnDesc d; d.Q = QM + hd * 192; d.K = KVM + hd * 256; d.K2 = WP(bf16, WS_H) + C_CKR; d.V = KVM + hd * 256 + 128; d.O = WP(bf16, WS_MIX) + 2048 + hd * 128; d.LSE = nullptr; d.cosT = WP(float, WS_COS64); d.sinT = WP(float, WS_SIN64);
                d.ldq = 1536; d.ldk = 2048; d.ldk2 = NINP; d.ldv = 2048; d.ldo = DM; d.lse_ld = 0; d.row0 = b * SEQ; d.rstride = 1; d.iq0 = qb * 256; d.W = 1 << 29; d.pos0 = 0; d.scale = 0.07216878364870323f;
                attn_unit<192, 0, true>(lds, d, tid, wave, lane);
            } }
            { PHL; gu32* ctl = WP(gu32, WS_CTL); bf16* H = WP(bf16, WS_H);
            QINIT();
            for (;;) {
                QFETCH(2, 320);
                AttnDesc d; d.K2 = nullptr; d.cosT = nullptr; d.sinT = nullptr; d.ldq = NINP; d.ldk = NINP; d.ldk2 = 0; d.ldv = NINP; d.ldo = 1024; d.pos0 = 0; d.scale = 0.08838834764831845f;
                if (qv < 128) {
                    const int qb = 31 - (qv >> 2), v = 4 * qx + (qv & 3), b = v / 16, vh = v % 16, hd = vh / 4, map = (vh / 2) % 2, half = vh % 2;
                    d.Q = H + C_DQ + hd * 256 + map * 128; d.K = H + C_DK + hd * 256 + map * 128; d.V = H + C_DV + hd * 256 + half * 128; d.O = WP(bf16, WS_DO) + (size_t)map * NTOK * 1024 + hd * 256 + half * 128; d.LSE = nullptr; d.lse_ld = 0;
                    d.row0 = b * SEQ; d.rstride = 1; d.iq0 = qb * 256; d.W = 1 << 29;
                } else {
                    const int w = qv - 128, pr = 2 * qx + w / 96, b = pr / 8, hd = pr % 8, r2 = w % 96, br = r2 / 32, idx = r2 % 32;
                    const int dil = br == 0 ? 1 : (br == 1 ? 4 : 16), nqb = 32 / dil, res = idx / nqb, qb = idx % nqb;
                    d.Q = H + C_BQ + hd * 128; d.K = H + C_BK + hd * 128; d.V = H + C_BV + hd * 128; d.O = WP(bf16, WS_DP) + (size_t)br * NTOK * 1024 + hd * 128; d.LSE = WP(float, WS_LSE) + (size_t)br * NTOK * 8 + hd; d.lse_ld = 8;
                    d.row0 = b * SEQ + res; d.rstride = dil; d.iq0 = qb * 256; d.W = 128;
                }
                attn_unit<128, 0, false>(lds, d, tid, wave, lane);
            } }
        }
        GRIDBAR();
        PH_ON(5) { PHL; const float lam_init = (L == 0) ? 0.2f : 0.35550906f;
          combine_rows(WP(bf16, WS_DP), WP(float, WS_LSE), WP(bf16, WS_DO), args.in[8] + (size_t)L * 512, args.in[9] + (size_t)L * 256, lam_init, WP(bf16, WS_MIX), gw, ngw, lane); }
        GRIDBAR();
        PH_ON(6) { PHL; pg8::Gemm g{WP(bf16, WS_MIX), WP(bf16, WS_WO), NTOK, DM, DM, DM}; pg8::StaticOrder S; S.init(NTOK, DM, G, (int)blockIdx.x); EpiB<0> E{WP(bf16, WS_Y), DM, nullptr};
          pg8::gemm_phase<EpiB<0>, pg8::StaticOrder, true, true>(lds, g, S, E); }
        GRIDBAR();
        PH_ON(7) { PHL; ln_rows(L == 0 ? args.in[0] : args.out, WP(bf16, WS_Y), args.in[10] + (size_t)L * DM, args.in[11] + (size_t)L * DM, args.out, WP(bf16, WS_XB), gw, ngw, lane); }
        GRIDBAR();
        PH_ON(8) { PHL; pg8::Gemm g{WP(bf16, WS_XB), WP(bf16, WS_FF1), NTOK, DFF, DM, DM}; pg8::StaticOrder S; S.init(NTOK, DFF, G, (int)blockIdx.x); EpiB<2> E{WP(bf16, WS_H), DFF, nullptr};
          pg8::gemm_phase<EpiB<2>, pg8::StaticOrder, true, true>(lds, g, S, E); }
        GRIDBAR();
        PH_ON(9) { PHL; pg8::Gemm g{WP(bf16, WS_H), WP(bf16, WS_FF2), NTOK, DM, DFF, DFF}; pg8::StaticOrder S; S.init(NTOK, DM, G, (int)blockIdx.x); EpiB<0> E{WP(bf16, WS_Y), DM, nullptr};
          pg8::gemm_phase<EpiB<0>, pg8::StaticOrder, true, true>(lds, g, S, E); }
        GRIDBAR();
        PH_ON(10) {
        { PHL; ln_rows(args.out, WP(bf16, WS_Y), args.in[14] + (size_t)L * DM, args.in[15] + (size_t)L * DM, args.out, WP(bf16, WS_XB), gw, ngw, lane); }
        __syncthreads();
        { PHL; pg8::Gemm g{WP(bf16, WS_PB), WP(bf16, WS_PROJ), NTOK, DM, PLE, PLE}; pg8::StaticOrder S; S.init(NTOK, DM, G, (int)blockIdx.x); EpiB<0> E{WP(bf16, WS_H), DM, nullptr};
          pg8::gemm_phase<EpiB<0>, pg8::StaticOrder, true, true>(lds, g, S, E); }
        }
        GRIDBAR();
        PH_ON(11) { PHL; pg8::Gemm g{WP(bf16, WS_XB), WP(bf16, WS_GATE), NTOK, DM, DM, DM}; pg8::StaticOrder S; S.init(NTOK, DM, G, (int)blockIdx.x); EpiG E{WP(bf16, WS_Y), WP(bf16, WS_H), DM};
          pg8::gemm_phase<EpiG, pg8::StaticOrder, true, true>(lds, g, S, E); }
        GRIDBAR();
        PH_ON(12) { PHL; ln_rows(args.out, WP(bf16, WS_Y), args.in[18] + (size_t)L * DM, args.in[19] + (size_t)L * DM, args.out, WP(bf16, WS_XB), gw, ngw, lane); }

    }
}
#else
template <int PH> __global__ void __launch_bounds__(512, 2) hybrid_ph(Args args) {

    extern __shared__ __attribute__((aligned(16))) unsigned char lds_raw[];
    LAS unsigned char* lds = (LAS unsigned char*)lds_raw;
    volatile LAS unsigned* MISC = (volatile LAS unsigned*)(lds + MISC_OFF);
    for (int u = threadIdx.x; u < (LDS_BYTES - RING_BYTES) / 4; u += 512) ((LAS unsigned*)(lds + RING_BYTES))[u] = 0u;
    __syncthreads();

    XcdBarrier bar; bar.bar = nullptr; bar.x = 0; bar.st = nullptr; (void)bar; (void)MISC;
    const int L = args.L;

        PH_ON(0) {
            PHL; const size_t gtid = (size_t)blockIdx.x * 512 + tid, gthreads = (size_t)G * 512;
            LAS float* scr = (LAS float*)(lds + wave * 16384);
            constexpr int I_IN = 64 * (NIN / 32), I_O = 64 * 128, I_UQ = 16 * 48, I_UKV = 8 * 64, I_F1 = 64 * 512, I_F2 = 256 * 128, I_G = 64 * 128, I_P = 4 * 128;
            constexpr int NITEMS = I_IN + I_O + I_UQ + I_UKV + I_F1 + I_F2 + I_G + I_P;
            for (int it = gw; it < NITEMS; it += ngw) {
                int r = it;
                if (r < I_IN) { transpose_item(args.in[2] + (size_t)L * DM * NIN, DM, NIN, WP(bf16, WS_WIN), nullptr, scr, r, lane); continue; } r -= I_IN;
                if (r < I_O) { transpose_item(args.in[3] + (size_t)L * DM * DM, DM, DM, WP(bf16, WS_WO), nullptr, scr, r, lane); continue; } r -= I_O;
                if (r < I_UQ) { transpose_item(args.in[5] + (size_t)L * 1024 * 1536, 1024, 1536, WP(bf16, WS_UQ), args.in[4] + (size_t)L * 1024, scr, r, lane); continue; } r -= I_UQ;
                if (r < I_UKV) { transpose_item(args.in[7] + (size_t)L * 512 * 2048, 512, 2048, WP(bf16, WS_UKV), args.in[6] + (size_t)L * 512, scr, r, lane); continue; } r -= I_UKV;
                if (r < I_F1) { transpose_item(args.in[12] + (size_t)L * DM * DFF, DM, DFF, WP(bf16, WS_FF1), nullptr, scr, r, lane); continue; } r -= I_F1;
                if (r < I_F2) { transpose_item(args.in[13] + (size_t)L * DFF * DM, DFF, DM, WP(bf16, WS_FF2), nullptr, scr, r, lane); continue; } r -= I_F2;
                if (r < I_G) { transpose_item(args.in[16] + (size_t)L * DM * DM, DM, DM, WP(bf16, WS_GATE), nullptr, scr, r, lane); continue; } r -= I_G;
                transpose_item(args.in[17] + (size_t)L * PLE * DM, PLE, DM, WP(bf16, WS_PROJ), nullptr, scr, r, lane);
            }
            { v4u z = {0u, 0u, 0u, 0u}; v4u* pad = (v4u*)(WP(bf16, WS_WIN) + (size_t)NIN * DM); const size_t n16 = (size_t)(NINP - NIN) * DM / 8; for (size_t i = gtid; i < n16; i += gthreads) pad[i] = z; }
            cvt_rows(args.in[1] + (size_t)L * NTOK * PLE, WP(bf16, WS_PB), (size_t)NTOK * PLE / 8, gtid, gthreads);
            if (L == 0) {
                cvt_rows(args.in[0], WP(bf16, WS_XB), (size_t)NTOK * DM / 8, gtid, gthreads);
                float* cos128 = WP(float, WS_COS128); float* sin128 = WP(float, WS_SIN128); float* cos64 = WP(float, WS_COS64); float* sin64 = WP(float, WS_SIN64);
                for (size_t i = gtid; i < (size_t)SEQ * 64; i += gthreads) { const int pos = (int)(i >> 6), j = (int)(i & 63); const float inv = powf(10000.0f, -(float)j / 64.0f); const float ang = (float)pos * inv; cos128[i] = cosf(ang); sin128[i] = sinf(ang); }
                for (size_t i = gtid; i < (size_t)SEQ * 32; i += gthreads) { const int pos = (int)(i >> 5), j = (int)(i & 31); const float inv = powf(10000.0f, -(float)j / 32.0f); const float ang = (float)pos * inv; cos64[i] = cosf(ang); sin64[i] = sinf(ang); }
            }
        }
        GRIDBAR();
        PH_ON(1) { PHL; pg8::Gemm g{WP(bf16, WS_XB), WP(bf16, WS_WIN), NTOK, NINP, DM, DM}; pg8::StaticOrder S; S.init(NTOK, NINP, G, (int)blockIdx.x); EpiB<0> E{WP(bf16, WS_H), NINP, nullptr};
          pg8::gemm_phase<EpiB<0>, pg8::StaticOrder, true, true>(lds, g, S, E); }
        GRIDBAR();
        PH_ON(2) { PHL; rope_rows(WP(bf16, WS_H), WP(float, WS_COS128), WP(float, WS_SIN128), WP(float, WS_COS64), WP(float, WS_SIN64), WP(float, WS_RSQ), WP(float, WS_RSKV), gw, ngw, lane); }
        GRIDBAR();
        PH_ON(3) {
        { PHL; pg8::Gemm g{WP(bf16, WS_H) + C_CQ, WP(bf16, WS_UQ), NTOK, 1536, 1024, NINP}; pg8::StaticOrder S; S.init(NTOK, 1536, G, (int)blockIdx.x); EpiB<0> E{WP(bf16, WS_QM), 1536, WP(float, WS_RSQ)};
          pg8::gemm_phase<EpiB<0>, pg8::StaticOrder, true, true>(lds, g, S, E); }
        __syncthreads();
        { PHL; pg8::Gemm g{WP(bf16, WS_H) + C_CKV, WP(bf16, WS_UKV), NTOK, 2048, 512, NINP}; pg8::StaticOrder S; S.init(NTOK, 2048, G, (int)blockIdx.x); EpiB<0> E{WP(bf16, WS_KVM), 2048, WP(float, WS_RSKV)};
          pg8::gemm_phase<EpiB<0>, pg8::StaticOrder, true, true>(lds, g, S, E); }
        }
        GRIDBAR();
        PH_ON(4) {
            LAS unsigned* uq = (LAS unsigned*)(lds + MISC_OFF + 64);
            { PHL; gu32* ctl = WP(gu32, WS_CTL); bf16* H = WP(bf16, WS_H); bf16* MIX = WP(bf16, WS_MIX);
            QINIT();
            for (;;) {
                QFETCH(0, 64);
                const int qb = 31 - (qv >> 1), bh = 2 * qx + (qv & 1), b = bh / 8, hd = bh % 8;
                AttnDesc d; d.Q = H + C_AQ + hd * 128; d.K = H + C_AK + hd * 128; d.K2 = nullptr; d.V = H + C_AV + hd * 128; d.O = MIX + hd * 128; d.LSE = nullptr; d.cosT = nullptr; d.sinT = nullptr;
                d.ldq = NINP; d.ldk = NINP; d.ldk2 = 0; d.ldv = NINP; d.ldo = DM; d.lse_ld = 0; d.row0 = b * SEQ; d.rstride = 1; d.iq0 = qb * 256; d.W = 1 << 29; d.pos0 = 0; d.scale = 0.08838834764831845f;
                attn_unit<128, 1, false>(lds, d, tid, wave, lane);
            } }
            { PHL; gu32* ctl = WP(gu32, WS_CTL); bf16* QM = WP(bf16, WS_QM); bf16* KVM = WP(bf16, WS_KVM);
            QINIT();
            for (;;) {
                QFETCH(1, 64);
                const int qb = 31 - (qv >> 1), bh = 2 * qx + (qv & 1), b = bh / 8, hd = bh % 8;
                AttnDesc d; d.Q = QM + hd * 192; d.K = KVM + hd * 256; d.K2 = WP(bf16, WS_H) + C_CKR; d.V = KVM + hd * 256 + 128; d.O = WP(bf16, WS_MIX) + 2048 + hd * 128; d.LSE = nullptr; d.cosT = WP(float, WS_COS64); d.sinT = WP(float, WS_SIN64);
                d.ldq = 1536; d.ldk = 2048; d.ldk2 = NINP; d.ldv = 2048; d.ldo = DM; d.lse_ld = 0; d.row0 = b * SEQ; d.rstride = 1; d.iq0 = qb * 256; d.W = 1 << 29; d.pos0 = 0; d.scale = 0.07216878364870323f;
                attn_unit<192, 0, true>(lds, d, tid, wave, lane);
            } }
            { PHL; gu32* ctl = WP(gu32, WS_CTL); bf16* H = WP(bf16, WS_H);
            QINIT();
            for (;;) {
                QFETCH(2, 320);
                AttnDesc d; d.K2 = nullptr; d.cosT = nullptr; d.sinT = nullptr; d.ldq = NINP; d.ldk = NINP; d.ldk2 = 0; d.ldv = NINP; d.ldo = 1024; d.pos0 = 0; d.scale = 0.08838834764831845f;
                if (qv < 128) {
                    const int qb = 31 - (qv >> 2), v = 4 * qx + (qv & 3), b = v / 16, vh = v % 16, hd = vh / 4, map = (vh / 2) % 2, half = vh % 2;
                    d.Q = H + C_DQ + hd * 256 + map * 128; d.K = H + C_DK + hd * 256 + map * 128; d.V = H + C_DV + hd * 256 + half * 128; d.O = WP(bf16, WS_DO) + (size_t)map * NTOK * 1024 + hd * 256 + half * 128; d.LSE = nullptr; d.lse_ld = 0;
                    d.row0 = b * SEQ; d.rstride = 1; d.iq0 = qb * 256; d.W = 1 << 29;
                } else {
                    const int w = qv - 128, pr = 2 * qx + w / 96, b = pr / 8, hd = pr % 8, r2 = w % 96, br = r2 / 32, idx = r2 % 32;
                    const int dil = br == 0 ? 1 : (br == 1 ? 4 : 16), nqb = 32 / dil, res = idx / nqb, qb = idx % nqb;
                    d.Q = H + C_BQ + hd * 128; d.K = H + C_BK + hd * 128; d.V = H + C_BV + hd * 128; d.O = WP(bf16, WS_DP) + (size_t)br * NTOK * 1024 + hd * 128; d.LSE = WP(float, WS_LSE) + (size_t)br * NTOK * 8 + hd; d.lse_ld = 8;
                    d.row0 = b * SEQ + res; d.rstride = dil; d.iq0 = qb * 256; d.W = 128;
                }
                attn_unit<128, 0, false>(lds, d, tid, wave, lane);
            } }
        }
        GRIDBAR();
        PH_ON(5) { PHL; const float lam_init = (L == 0) ? 0.2f : 0.35550906f;
          combine_rows(WP(bf16, WS_DP), WP(float, WS_LSE), WP(bf16, WS_DO), args.in[8] + (size_t)L * 512, args.in[9] + (size_t)L * 256, lam_init, WP(bf16, WS_MIX), gw, ngw, lane); }
        GRIDBAR();
        PH_ON(6) { PHL; pg8::Gemm g{WP(bf16, WS_MIX), WP(bf16, WS_WO), NTOK, DM, DM, DM}; pg8::StaticOrder S; S.init(NTOK, DM, G, (int)blockIdx.x); EpiB<0> E{WP(bf16, WS_Y), DM, nullptr};
          pg8::gemm_phase<EpiB<0>, pg8::StaticOrder, true, true>(lds, g, S, E); }
        GRIDBAR();
        PH_ON(7) { PHL; ln_rows(L == 0 ? args.in[0] : args.out, WP(bf16, WS_Y), args.in[10] + (size_t)L * DM, args.in[11] + (size_t)L * DM, args.out, WP(bf16, WS_XB), gw, ngw, lane); }
        GRIDBAR();
        PH_ON(8) { PHL; pg8::Gemm g{WP(bf16, WS_XB), WP(bf16, WS_FF1), NTOK, DFF, DM, DM}; pg8::StaticOrder S; S.init(NTOK, DFF, G, (int)blockIdx.x); EpiB<2> E{WP(bf16, WS_H), DFF, nullptr};
          pg8::gemm_phase<EpiB<2>, pg8::StaticOrder, true, true>(lds, g, S, E); }
        GRIDBAR();
        PH_ON(9) { PHL; pg8::Gemm g{WP(bf16, WS_H), WP(bf16, WS_FF2), NTOK, DM, DFF, DFF}; pg8::StaticOrder S; S.init(NTOK, DM, G, (int)blockIdx.x); EpiB<0> E{WP(bf16, WS_Y), DM, nullptr};
          pg8::gemm_phase<EpiB<0>, pg8::StaticOrder, true, true>(lds, g, S, E); }
        GRIDBAR();
        PH_ON(10) {
        { PHL; ln_rows(args.out, WP(bf16, WS_Y), args.in[14] + (size_t)L * DM, args.in[15] + (size_t)L * DM, args.out, WP(bf16, WS_XB), gw, ngw, lane); }
        __syncthreads();
        { PHL; pg8::Gemm g{WP(bf16, WS_PB), WP(bf16, WS_PROJ), NTOK, DM, PLE, PLE}; pg8::StaticOrder S; S.init(NTOK, DM, G, (int)blockIdx.x); EpiB<0> E{WP(bf16, WS_H), DM, nullptr};
          pg8::gemm_phase<EpiB<0>, pg8::StaticOrder, true, true>(lds, g, S, E); }
        }
        GRIDBAR();
        PH_ON(11) { PHL; pg8::Gemm g{WP(bf16, WS_XB), WP(bf16, WS_GATE), NTOK, DM, DM, DM}; pg8::StaticOrder S; S.init(NTOK, DM, G, (int)blockIdx.x); EpiG E{WP(bf16, WS_Y), WP(bf16, WS_H), DM};
          pg8::gemm_phase<EpiG, pg8::StaticOrder, true, true>(lds, g, S, E); }
        GRIDBAR();
        PH_ON(12) { PHL; ln_rows(args.out, WP(bf16, WS_Y), args.in[18] + (size_t)L * DM, args.in[19] + (size_t)L * DM, args.out, WP(bf16, WS_XB), gw, ngw, lane); }

}
template <int PH> static void launch_ph(int grid, hipStream_t stream, Args a) {
    static bool attr = false;
    if (!attr) { (void)hipFuncSetAttribute((const void*)hybrid_ph<PH>, hipFuncAttributeMaxDynamicSharedMemorySize, LDS_BYTES); attr = true; }
    hipLaunchKernelGGL(hybrid_ph<PH>, dim3(grid), dim3(512), LDS_BYTES, stream, a);
}
#endif

extern "C" void kernel_launch(void* const* d_in, const int* in_sizes, int n_in, void* d_out, int out_size, void* d_ws, size_t ws_size, hipStream_t stream) {
    static int grid = 0;
    if (grid == 0) {
        if (n_in != 20 || out_size != NTOK * DM || ws_size < WS_END) { fprintf(stderr, "kernel_launch: unexpected shapes (n_in %d out %d ws %zu)\n", n_in, out_size, ws_size); grid = -1; return; }
        int dev = 0, cus = 0;
        if (hipGetDevice(&dev) != hipSuccess || hipDeviceGetAttribute(&cus, hipDeviceAttributeMultiprocessorCount, dev) != hipSuccess) { grid = -1; return; }
#if ONE_LAUNCH
        int per_cu = 0;
        if (hipFuncSetAttribute((const void*)hybrid_one, hipFuncAttributeMaxDynamicSharedMemorySize, LDS_BYTES) != hipSuccess) { fprintf(stderr, "kernel_launch: hipFuncSetAttribute failed\n"); grid = -1; return; }
        if (hipOccupancyMaxActiveBlocksPerMultiprocessor(&per_cu, (const void*)hybrid_one, 512, LDS_BYTES) != hipSuccess || per_cu < 1) { fprintf(stderr, "kernel_launch: occupancy query says %d blocks per CU\n", per_cu); }
        (void)hipGetLastError();
#endif
        grid = cus;
    }
    if (grid < 0) return;
    if (hipMemsetAsync((char*)d_ws + WS_CTL, 0, CTL_ZERO_BYTES, stream) != hipSuccess) return;
    Args a{};
    for (int i = 0; i < 20; ++i) a.in[i] = (const float*)d_in[i];
    a.out = (float*)d_out; a.ws = (unsigned char*)d_ws; a.L = 0; a.pad = 0;
#if ONE_LAUNCH
    hipLaunchKernelGGL(hybrid_one, dim3(grid), dim3(512), LDS_BYTES, stream, a);
#else
    for (int L = 0; L < 2; ++L) { a.L = L;
        launch_ph<0>(grid, stream, a); launch_ph<1>(grid, stream, a); launch_ph<2>(grid, stream, a); launch_ph<3>(grid, stream, a); launch_ph<4>(grid, stream, a); launch_ph<5>(grid, stream, a); launch_ph<6>(grid, stream, a);
        launch_ph<7>(grid, stream, a); launch_ph<8>(grid, stream, a); launch_ph<9>(grid, stream, a); launch_ph<10>(grid, stream, a); launch_ph<11>(grid, stream, a); launch_ph<12>(grid, stream, a); }
#endif
}
```

```cpp
#include <hip/hip_runtime.h>
#include <cstdio>
#include <cstdint>
namespace pg8 {
#define PG8_LAS __attribute__((address_space(3)))
typedef unsigned short bf16_t;
typedef short bf16x8 __attribute__((ext_vector_type(8)));
typedef float f32x4 __attribute__((ext_vector_type(4)));
typedef unsigned u32x4 __attribute__((ext_vector_type(4)));
constexpr int BM = 256, BK = 64, HALF = 128, HTB = HALF * BK * 2  , STAGE_BYTES = 8 * HTB, NXCD = 8, WGM = 8;

__host__ __device__ __forceinline__ int lds_byte(int r, int c) { const int st = (r >> 4) * 2 + (c >> 5), rr = r & 15, cc = c & 31, ob = rr * 64 + cc * 2; return st * 1024 + (ob ^ (((ob >> 9) & 1) << 5)); }
__host__ __device__ __forceinline__ void stage_rc(int b, int& R, int& C) { const int st = b / 1024, sb = b % 1024, swz = sb ^ (((sb >> 9) & 1) << 5); R = (st >> 1) * 16 + swz / 64; C = (st & 1) * 32 + (swz % 64) / 2; }
__host__ __device__ __forceinline__ int perm32(int rho) { const int n = rho >> 4, i = rho & 15; return 8 * (i >> 2) + 4 * n + (i & 3); }

struct Unit { int pm, pn; };
struct Gemm { const bf16_t* A; const bf16_t* Bt; int M, N, K, lda; };

struct StaticOrder {
    int nM, nN, nwg, G, c;
    __host__ __device__ void init(int M, int N, int G_, int c_) { nM = M / BM; nN = N / BM; nwg = nM * nN; G = G_; c = c_; }
    __host__ __device__ bool next(int i, Unit& u) const {
        const long L = (long)i * G + c; if (L >= nwg) return false;
        int wgid = (int)L; { const int q = nwg / NXCD, r = nwg % NXCD, xcd = wgid % NXCD, off = wgid / NXCD; wgid = (xcd < r ? xcd * (q + 1) : r * (q + 1) + (xcd - r) * q) + off; }
        const int nig = WGM * nN, gid = wgid / nig, fm = gid * WGM, gsz = (nM - fm) < WGM ? (nM - fm) : WGM;
        u.pm = fm + ((wgid % nig) % gsz); u.pn = (wgid % nig) / gsz; return true;
    }
    __device__ __forceinline__ void a_ready(const Unit&) const {}
    __device__ __forceinline__ void done(const Unit&) const {}
};

__device__ __forceinline__ unsigned cvt_pk_bf16(float lo, float hi) { unsigned r; asm volatile("v_cvt_pk_bf16_f32 %0, %1, %2" : "=v"(r) : "v"(lo), "v"(hi)); return r; }
typedef float f32x2 __attribute__((ext_vector_type(2)));
__device__ __forceinline__ f32x2 gelu_pk(f32x2 v) {
    const f32x2 av = __builtin_elementwise_abs(v), d = av * 0.2316418882f + 1.0f;
    f32x2 t; t.x = __builtin_amdgcn_rcpf(d.x); t.y = __builtin_amdgcn_rcpf(d.y);
    f32x2 q = t * 0.5307027145f + (-0.7265760135f); q = q * t + 0.7107068705f; q = q * t + (-0.142248368f); q = q * t + 0.127414796f; q = q * t;
    const f32x2 s = (v * v) * (-0.72134752044f);
    f32x2 e; e.x = __builtin_amdgcn_exp2f(s.x); e.y = __builtin_amdgcn_exp2f(s.y);
    const f32x2 m = v * (q * e), r = v - m;
    f32x2 o; o.x = v.x < 0.f ? m.x : r.x; o.y = v.y < 0.f ? m.y : r.y; return o;
}

template <int ACT  > struct EpiBf16 {
    static constexpr bool PERM = true, AFTER_DRAIN = false; static_assert(ACT == 0 || ACT == 1, "EpiBf16: ACT is 0 (none) or 1 (gelu_pk)");
    bf16_t* O; int ldc; const float* bias; int split_cols; size_t split_stride; float scale0;
    __device__ __forceinline__ void operator()(const f32x4 (&acc)[2][2][4][2], const Unit& u, int wr, int wc, int fr, int fq) const {
        const int row0 = u.pm * BM + wr * 64 + fr; int colt = u.pn * BM; bf16_t* base = O;
        float sc = 1.f; if (split_cols) { const int t = colt / split_cols; base += (size_t)t * split_stride; colt -= t * split_cols; if (t == 0) sc = scale0; }
        const int col0 = colt + wc * 32 + 8 * fq, bcol0 = u.pn * BM + wc * 32 + 8 * fq;
        f32x4 bv[2][2];
#pragma unroll
        for (int bj = 0; bj < 2; ++bj)
#pragma unroll
            for (int n = 0; n < 2; ++n) bv[bj][n] = bias ? *(const f32x4*)(bias + bcol0 + bj * HALF + 4 * n) : (f32x4){0.f, 0.f, 0.f, 0.f};
#pragma unroll
        for (int ai = 0; ai < 2; ++ai)
#pragma unroll
            for (int m = 0; m < 4; ++m) { bf16_t* rowp = base + (size_t)(row0 + ai * HALF + m * 16) * ldc + col0;
#pragma unroll
                for (int bj = 0; bj < 2; ++bj) { f32x4 v0 = acc[ai][bj][m][0] + bv[bj][0], v1 = acc[ai][bj][m][1] + bv[bj][1];
                    if (ACT == 1) { f32x2 a = gelu_pk((f32x2){v0[0], v0[1]}), b = gelu_pk((f32x2){v0[2], v0[3]}), c = gelu_pk((f32x2){v1[0], v1[1]}), d = gelu_pk((f32x2){v1[2], v1[3]});
                        v0 = (f32x4){a.x, a.y, b.x, b.y}; v1 = (f32x4){c.x, c.y, d.x, d.y}; }
                    v0 = v0 * sc; v1 = v1 * sc; u32x4 w; w.x = cvt_pk_bf16(v0[0], v0[1]); w.y = cvt_pk_bf16(v0[2], v0[3]); w.z = cvt_pk_bf16(v1[0], v1[1]); w.w = cvt_pk_bf16(v1[2], v1[3]);
                    *(u32x4*)(rowp + bj * HALF) = w; } }
    }
};

struct PanelStats {
    unsigned* xbuf;
    unsigned* cnt;
    unsigned* tmo;
    int ntn; float eps;
    unsigned code;
    __device__ __forceinline__ bool run(const f32x4 (&v)[2][2][4][2], const Unit& u, int wr, int wc, int fr, int fq, PG8_LAS unsigned char* lds, int wid, int lane) const {
        typedef float f32x2v __attribute__((ext_vector_type(2)));
        PG8_LAS f32x2v* P = (PG8_LAS f32x2v*)lds;
        PG8_LAS f32x2v* S = (PG8_LAS f32x2v*)(lds + 8192);
        PG8_LAS unsigned* flag = (PG8_LAS unsigned*)(lds + 8192 + 2048);
#pragma unroll
        for (int ai = 0; ai < 2; ++ai)
#pragma unroll
            for (int m = 0; m < 4; ++m) {
                float s = 0.f;
#pragma unroll
                for (int bj = 0; bj < 2; ++bj)
#pragma unroll
                    for (int n = 0; n < 2; ++n) { const f32x4 x = v[ai][bj][m][n]; s += (x[0] + x[1]) + (x[2] + x[3]); }
                s += __shfl_xor(s, 16); s += __shfl_xor(s, 32);
                const float mw = s * (1.0f / 64.0f); float q = 0.f;
#pragma unroll
                for (int bj = 0; bj < 2; ++bj)
#pragma unroll
                    for (int n = 0; n < 2; ++n) { const f32x4 d = v[ai][bj][m][n] - mw; q += (d[0] * d[0] + d[1] * d[1]) + (d[2] * d[2] + d[3] * d[3]); }
                q += __shfl_xor(q, 16); q += __shfl_xor(q, 32);
                if (fq == 0) P[(ai * HALF + wr * 64 + m * 16 + fr) * 4 + wc] = (f32x2v){mw, q};
            }
        asm volatile("s_waitcnt lgkmcnt(0)" ::: "memory"); __builtin_amdgcn_s_barrier(); asm volatile("" ::: "memory");
#if defined(BROKEN_EXCHANGE_NO_WAIT)
#warning BROKEN CONTROL BUILD: the row-statistics exchange does not wait; results are wrong by design
        if (blockIdx.x >= 64) { const long long t0_ = clock64(); while (clock64() - t0_ < 60000) __builtin_amdgcn_s_sleep(8); }
#endif
        const int row = wid * 32 + (lane & 31);
        if (lane < 32) {
            const f32x2v a = P[row * 4 + 0], b = P[row * 4 + 1], c = P[row * 4 + 2], d = P[row * 4 + 3];
            const float mt = (a.x + b.x + c.x + d.x) * 0.25f;
            const float da = a.x - mt, db = b.x - mt, dc = c.x - mt, dd = d.x - mt;
            const float m2 = (a.y + b.y) + (c.y + d.y) + 64.0f * ((da * da + db * db) + (dc * dc + dd * dd));
            unsigned long long* slot = (unsigned long long*)xbuf + ((size_t)(u.pm * BM + row) * 4 + u.pn);
            __hip_atomic_store(slot, ((unsigned long long)__float_as_uint(m2) << 32) | __float_as_uint(mt), __ATOMIC_RELAXED, __HIP_MEMORY_SCOPE_AGENT);
        }
        asm volatile("s_waitcnt vmcnt(0)" ::: "memory");
        if (lane == 0) __hip_atomic_fetch_add(cnt + 64 * u.pm, 1u, __ATOMIC_RELAXED, __HIP_MEMORY_SCOPE_AGENT);
        if (wid == 0) {
            bool dead = false; const unsigned long long t0 = __builtin_amdgcn_s_memrealtime(); const unsigned want = 8u * (unsigned)ntn;
            for (;;) {
#if defined(BROKEN_EXCHANGE_NO_WAIT)
                break;
#endif
                if ((unsigned)__builtin_amdgcn_readfirstlane(__hip_atomic_load(cnt + 64 * u.pm, __ATOMIC_RELAXED, __HIP_MEMORY_SCOPE_AGENT)) >= want) break;
                if (__builtin_amdgcn_s_memrealtime() - t0 > 2000000ull) {
                    if (lane == 0) { unsigned expect = 0u; __hip_atomic_compare_exchange_strong(tmo + 1, &expect, code | (unsigned)(u.pm & 0xff), __ATOMIC_RELAXED, __ATOMIC_RELAXED, __HIP_MEMORY_SCOPE_AGENT);
                                     __hip_atomic_store(tmo, 1u, __ATOMIC_RELAXED, __HIP_MEMORY_SCOPE_AGENT); }
                    dead = true; break; }
                __builtin_amdgcn_s_sleep(2);
            }
            __builtin_amdgcn_fence(__ATOMIC_ACQUIRE, "agent");
            if (lane == 0) flag[0] = dead ? 1u : 0u;
        }
        asm volatile("s_waitcnt vmcnt(0) lgkmcnt(0)" ::: "memory"); __builtin_amdgcn_s_barrier(); asm volatile("" ::: "memory");
        const bool bad = flag[0] != 0u;
        if (lane < 32) {
            const unsigned long long* slot = (const unsigned long long*)xbuf + (size_t)(u.pm * BM + row) * 4; float mt[4], m2[4]; float ms = 0.f;
#pragma unroll
            for (int t = 0; t < 4; ++t) { if (t < ntn) { const unsigned long long w = __hip_atomic_load(slot + t, __ATOMIC_RELAXED, __HIP_MEMORY_SCOPE_AGENT); mt[t] = __uint_as_float((unsigned)w); m2[t] = __uint_as_float((unsigned)(w >> 32)); } else { mt[t] = 0.f; m2[t] = 0.f; } ms += mt[t]; }
            const float mean = ms / (float)ntn; float q = 0.f;
#pragma unroll
            for (int t = 0; t < 4; ++t) if (t < ntn) { const float dm = mt[t] - mean; q += m2[t] + 256.0f * dm * dm; }
            S[row] = (f32x2v){mean, 1.0f / sqrtf(q / (256.0f * (float)ntn) + eps)};
        }
        asm volatile("s_waitcnt lgkmcnt(0)" ::: "memory"); __builtin_amdgcn_s_barrier(); asm volatile("" ::: "memory");
        return bad;
    }
};
struct EpiLnRes {
    static constexpr bool PERM = false, AFTER_DRAIN = true;
    const float* base; float* out; int ldc; const float* bias; PanelStats st; unsigned poison;
    __device__ __forceinline__ void fused(f32x4 (&acc)[2][2][4][2], const Unit& u, int wr, int wc, int fr, int fq, PG8_LAS unsigned char* lds, int wid, int lane) const {
        typedef float f32x2v __attribute__((ext_vector_type(2)));
        const PG8_LAS f32x2v* S = (const PG8_LAS f32x2v*)(lds + 8192);
        const int col0 = u.pn * BM + wc * 32 + 4 * fq;
#pragma unroll
        for (int bj = 0; bj < 2; ++bj)
#pragma unroll
            for (int n = 0; n < 2; ++n) { const f32x4 bv = bias ? *(const f32x4*)(bias + col0 + bj * HALF + n * 16) : (f32x4){0.f, 0.f, 0.f, 0.f};
#pragma unroll
                for (int ai = 0; ai < 2; ++ai)
#pragma unroll
                    for (int m = 0; m < 4; ++m) acc[ai][bj][m][n] += bv; }
        f32x4 pre[4][2][2];
#pragma unroll
        for (int m = 0; m < 4; ++m) { const size_t off = (size_t)(u.pm * BM + wr * 64 + m * 16 + fr) * ldc + col0;
#pragma unroll
            for (int bj = 0; bj < 2; ++bj)
#pragma unroll
                for (int n = 0; n < 2; ++n) pre[m][bj][n] = *(const f32x4*)(base + off + bj * HALF + n * 16); }
        const bool bad = st.run(acc, u, wr, wc, fr, fq, lds, wid, lane) || poison != 0u;
        const float qnan = __builtin_nanf("");
#pragma unroll
        for (int ai = 0; ai < 2; ++ai)
#pragma unroll
            for (int m = 0; m < 4; ++m) { const int r = ai * HALF + wr * 64 + m * 16 + fr; const f32x2v sr = S[r]; const size_t off = (size_t)(u.pm * BM + r) * ldc + col0;
#pragma unroll
                for (int bj = 0; bj < 2; ++bj)
#pragma unroll
                    for (int n = 0; n < 2; ++n) { const f32x4 bs = ai == 0 ? pre[m][bj][n] : *(const f32x4*)(base + off + bj * HALF + n * 16); f32x4 o = bs + (acc[ai][bj][m][n] - sr.x) * sr.y;
                        if (bad) o = (f32x4){qnan, qnan, qnan, qnan}; *(f32x4*)(out + off + bj * HALF + n * 16) = o; }
                if (m & 1) asm volatile("" ::: "memory"); }
    }
};
struct EpiLnResLn {
    static constexpr bool PERM = false, AFTER_DRAIN = true;
    const float* base; float* out; bf16_t* xn; int ldc; const float* bias; PanelStats st1, st2; unsigned poison;
    __device__ __forceinline__ void fused(f32x4 (&acc)[2][2][4][2], const Unit& u, int wr, int wc, int fr, int fq, PG8_LAS unsigned char* lds, int wid, int lane) const {
        typedef float f32x2v __attribute__((ext_vector_type(2))); typedef unsigned u32x2v __attribute__((ext_vector_type(2)));
        const PG8_LAS f32x2v* S = (const PG8_LAS f32x2v*)(lds + 8192);
        const int col0 = u.pn * BM + wc * 32 + 4 * fq;
#pragma unroll
        for (int bj = 0; bj < 2; ++bj)
#pragma unroll
            for (int n = 0; n < 2; ++n) { const f32x4 bv = bias ? *(const f32x4*)(bias + col0 + bj * HALF + n * 16) : (f32x4){0.f, 0.f, 0.f, 0.f};
#pragma unroll
                for (int ai = 0; ai < 2; ++ai)
#pragma unroll
                    for (int m = 0; m < 4; ++m) acc[ai][bj][m][n] += bv; }
        bool bad = st1.run(acc, u, wr, wc, fr, fq, lds, wid, lane) || poison != 0u;
        const float qnan = __builtin_nanf("");
#pragma unroll
        for (int ai = 0; ai < 2; ++ai)
#pragma unroll
            for (int m = 0; m < 4; ++m) { const int r = ai * HALF + wr * 64 + m * 16 + fr; const f32x2v sr = S[r]; const size_t off = (size_t)(u.pm * BM + r) * ldc + col0;
#pragma unroll
                for (int bj = 0; bj < 2; ++bj)
#pragma unroll
                    for (int n = 0; n < 2; ++n) { const f32x4 bs = *(const f32x4*)(base + off + bj * HALF + n * 16); acc[ai][bj][m][n] = bs + (acc[ai][bj][m][n] - sr.x) * sr.y; }
                asm volatile("" : "+v"(acc[ai][0][m][0]), "+v"(acc[ai][0][m][1]), "+v"(acc[ai][1][m][0]), "+v"(acc[ai][1][m][1]));
                if (m & 1) asm volatile("" ::: "memory"); }
        const bool bad1 = bad;
        bad = st2.run(acc, u, wr, wc, fr, fq, lds, wid, lane) || bad;
#pragma unroll
        for (int ai = 0; ai < 2; ++ai)
#pragma unroll
            for (int m = 0; m < 4; ++m) { const int r = ai * HALF + wr * 64 + m * 16 + fr; const f32x2v sr = S[r]; const size_t off = (size_t)(u.pm * BM + r) * ldc + col0;
#pragma unroll
                for (int bj = 0; bj < 2; ++bj)
#pragma unroll
                    for (int n = 0; n < 2; ++n) { const f32x4 x1 = acc[ai][bj][m][n]; *(f32x4*)(out + off + bj * HALF + n * 16) = bad1 ? (f32x4){qnan, qnan, qnan, qnan} : x1;
                        const f32x4 o = (x1 - sr.x) * sr.y; u32x2v w; w.x = cvt_pk_bf16(o[0], o[1]); w.y = cvt_pk_bf16(o[2], o[3]);
                        if (bad) { w.x = 0x7fc07fc0u; w.y = 0x7fc07fc0u; } *(u32x2v*)(xn + off + bj * HALF + n * 16) = w; }
                asm volatile("" ::: "memory"); }
    }
};

template <class Epi, class Sched, bool ALIGN_EPI = false, bool SP2 = false>
__device__ __forceinline__ void gemm_phase(PG8_LAS unsigned char* lds, const Gemm g, const Sched& S, const Epi& E) {
    int tid = threadIdx.x; asm volatile("" : "+v"(tid));
    const int wid = __builtin_amdgcn_readfirstlane(tid >> 6), lane = tid & 63, wr = wid >> 2, wc = wid & 3, fr = lane & 15, fq = lane >> 4;
    const int K = g.K, nt = K / BK;
    unsigned voffA[2], voffB[2];
#pragma unroll
    for (int i = 0; i < 2; ++i) { int R, C; stage_rc(tid * 16 + i * 8192, R, C); const int Rb = Epi::PERM ? ((R & ~31) + perm32(R & 31)) : R;
        voffA[i] = (unsigned)(R * g.lda + C) * 2u; voffB[i] = (unsigned)(Rb * K + C) * 2u; }
    const size_t kstep = (size_t)(BK * 2);
    const size_t hstepB = (size_t)HALF * K * 2, hstepA = (size_t)HALF * g.lda * 2;
    const size_t tstepB = 2 * hstepB, tstepA = 2 * hstepA;
    const unsigned ldsw = (unsigned)wid * 1024u;
    const int aoff = lds_byte(wr * 64 + fr, fq * 8), boff = lds_byte(wc * 32 + fr, fq * 8);
#define PG8_SA(b, h) (((b) * 2 + (h)) * HTB)
#define PG8_SB(b, h) ((4 + (b) * 2 + (h)) * HTB)
#define PG8_STAGE(bufoff, gbase, voff) do { _Pragma("unroll") for (int _i = 0; _i < 2; ++_i) \
        __builtin_amdgcn_global_load_lds((const unsigned*)((const char*)(gbase) + (voff)[_i]), (PG8_LAS unsigned*)(lds + (bufoff) + ldsw + _i * 8192), 16, 0, 0); } while (0)
#define PG8_LDA(dst, b, h) do { _Pragma("unroll") for (int m = 0; m < 4; ++m) _Pragma("unroll") for (int k = 0; k < 2; ++k) dst[m][k] = *(const PG8_LAS bf16x8*)(lds + PG8_SA(b, h) + aoff + m * 2048 + k * 1024); } while (0)
#define PG8_LDB(dst, b, h) do { _Pragma("unroll") for (int n = 0; n < 2; ++n) _Pragma("unroll") for (int k = 0; k < 2; ++k) dst[n][k] = *(const PG8_LAS bf16x8*)(lds + PG8_SB(b, h) + boff + n * 2048 + k * 1024); } while (0)
#define PG8_MMA(ai, bj, At, Bt) do { __builtin_amdgcn_s_setprio(1); _Pragma("unroll") for (int m = 0; m < 4; ++m) _Pragma("unroll") for (int n = 0; n < 2; ++n) _Pragma("unroll") for (int k = 0; k < 2; ++k) \
        acc[ai][bj][m][n] = __builtin_amdgcn_mfma_f32_16x16x32_bf16(Bt[n][k], At[m][k], acc[ai][bj][m][n], 0, 0, 0); __builtin_amdgcn_s_setprio(0); } while (0)
#define PG8_WAIT_V(n) asm volatile("s_waitcnt vmcnt(" #n ")" ::: "memory")
#define PG8_WAIT_L(n) asm volatile("s_waitcnt lgkmcnt(" #n ")" ::: "memory")
#define PG8_BAR __builtin_amdgcn_s_barrier()
#define PG8_SCHED __builtin_amdgcn_sched_barrier(0)
    Unit cur, nxt; int ui = 0;
    if (!S.next(0, cur)) return;
    f32x4 acc[2][2][4][2];
#pragma unroll
    for (int a = 0; a < 2; ++a)
#pragma unroll
        for (int b = 0; b < 2; ++b)
#pragma unroll
            for (int m = 0; m < 4; ++m)
#pragma unroll
                for (int n = 0; n < 2; ++n) acc[a][b][m][n] = (f32x4){0.f, 0.f, 0.f, 0.f};
    bf16x8 At[4][2], B0[2][2], B1[2][2];
    const char* cA = (const char*)g.A + (size_t)cur.pm * tstepA; const char* cB = (const char*)g.Bt + (size_t)cur.pn * tstepB;
    S.a_ready(cur);
    if constexpr (SP2) {
        PG8_STAGE(PG8_SB(0, 0), cB, voffB); PG8_STAGE(PG8_SB(0, 1), cB + hstepB, voffB); PG8_STAGE(PG8_SA(0, 0), cA, voffA); PG8_STAGE(PG8_SA(0, 1), cA + hstepA, voffA);
        if (wr == 1) PG8_BAR;
        PG8_WAIT_V(2); PG8_BAR;
        PG8_STAGE(PG8_SB(1, 0), cB + kstep, voffB); PG8_STAGE(PG8_SA(1, 0), cA + kstep, voffA); PG8_STAGE(PG8_SB(1, 1), cB + hstepB + kstep, voffB);
        PG8_WAIT_V(6); PG8_BAR;
    } else {
        PG8_STAGE(PG8_SB(0, 0), cB, voffB); PG8_STAGE(PG8_SA(0, 0), cA, voffA); PG8_STAGE(PG8_SB(0, 1), cB + hstepB, voffB); PG8_STAGE(PG8_SA(0, 1), cA + hstepA, voffA);
        if (wr == 1) PG8_BAR;
        PG8_WAIT_V(4); PG8_BAR;
        PG8_STAGE(PG8_SB(1, 0), cB + kstep, voffB); PG8_STAGE(PG8_SA(1, 0), cA + kstep, voffA); PG8_STAGE(PG8_SB(1, 1), cB + hstepB + kstep, voffB);
        PG8_WAIT_V(6); PG8_BAR;
    }
    for (;;) {
        const bool has_next = S.next(ui + 1, nxt);
        const char* nA = has_next ? (const char*)g.A + (size_t)nxt.pm * tstepA : cA; const char* nB = has_next ? (const char*)g.Bt + (size_t)nxt.pn * tstepB : cB;
        for (int t = 0; t < nt; t += 2) {
            const bool last = (t == nt - 2);
            const char* a1 = cA + (size_t)(t + 1) * kstep;
            const char* a2 = last ? nA : cA + (size_t)(t + 2) * kstep; const char* b2 = last ? nB : cB + (size_t)(t + 2) * kstep;
            const char* a3 = a2 + kstep; const char* b3 = b2 + kstep;
            if (last && has_next) S.a_ready(nxt);
            if constexpr (SP2) {
            PG8_LDB(B0, 0, 0); PG8_LDB(B1, 0, 1); PG8_SCHED; PG8_LDA(At, 0, 0); PG8_STAGE(PG8_SA(1, 1), a1 + hstepA, voffA);
            PG8_WAIT_V(8); PG8_WAIT_L(0); PG8_BAR; PG8_MMA(0, 0, At, B0); PG8_MMA(0, 1, At, B1); PG8_BAR; PG8_SCHED;
            PG8_LDA(At, 0, 1); PG8_STAGE(PG8_SB(0, 0), b2, voffB); PG8_STAGE(PG8_SB(0, 1), b2 + hstepB, voffB); PG8_STAGE(PG8_SA(0, 0), a2, voffA);
            PG8_WAIT_V(8); PG8_WAIT_L(0); PG8_BAR; PG8_MMA(1, 0, At, B0); PG8_MMA(1, 1, At, B1); PG8_BAR; PG8_SCHED;
            PG8_LDB(B0, 1, 0); PG8_LDB(B1, 1, 1); PG8_SCHED; PG8_LDA(At, 1, 0); PG8_STAGE(PG8_SA(0, 1), a2 + hstepA, voffA);
            PG8_WAIT_V(8); PG8_WAIT_L(0); PG8_BAR; PG8_MMA(0, 0, At, B0); PG8_MMA(0, 1, At, B1); PG8_BAR; PG8_SCHED;
            PG8_LDA(At, 1, 1); PG8_STAGE(PG8_SB(1, 0), b3, voffB); PG8_STAGE(PG8_SB(1, 1), b3 + hstepB, voffB); PG8_STAGE(PG8_SA(1, 0), a3, voffA);
            PG8_WAIT_V(8); PG8_WAIT_L(0); PG8_BAR; PG8_MMA(1, 0, At, B0); PG8_MMA(1, 1, At, B1); PG8_BAR; PG8_SCHED;
            } else {
            PG8_LDB(B0, 0, 0); PG8_SCHED; PG8_LDA(At, 0, 0); PG8_STAGE(PG8_SA(1, 1), a1 + hstepA, voffA);
            PG8_WAIT_L(8); PG8_BAR; PG8_WAIT_L(0); PG8_MMA(0, 0, At, B0); PG8_BAR; PG8_SCHED;
            PG8_LDB(B1, 0, 1); PG8_STAGE(PG8_SB(0, 0), b2, voffB);
            PG8_BAR; PG8_WAIT_L(0); PG8_MMA(0, 1, At, B1); PG8_BAR;
            PG8_LDA(At, 0, 1); PG8_STAGE(PG8_SA(0, 0), a2, voffA);
            PG8_BAR; PG8_WAIT_L(0); PG8_MMA(1, 0, At, B0); PG8_BAR; PG8_SCHED;
            PG8_STAGE(PG8_SB(0, 1), b2 + hstepB, voffB);
            PG8_WAIT_V(6); PG8_BAR; PG8_MMA(1, 1, At, B1); PG8_BAR;
            PG8_LDB(B0, 1, 0); PG8_SCHED; PG8_LDA(At, 1, 0); PG8_STAGE(PG8_SA(0, 1), a2 + hstepA, voffA);
            PG8_WAIT_L(8); PG8_BAR; PG8_WAIT_L(0); PG8_MMA(0, 0, At, B0); PG8_BAR; PG8_SCHED;
            PG8_LDB(B1, 1, 1); PG8_STAGE(PG8_SB(1, 0), b3, voffB);
            PG8_BAR; PG8_WAIT_L(0); PG8_MMA(0, 1, At, B1); PG8_BAR;
            PG8_LDA(At, 1, 1); PG8_STAGE(PG8_SA(1, 0), a3, voffA);
            PG8_BAR; PG8_WAIT_L(0); PG8_MMA(1, 0, At, B0); PG8_BAR; PG8_SCHED;
            PG8_STAGE(PG8_SB(1, 1), b3 + hstepB, voffB);
            PG8_WAIT_V(6); PG8_BAR; PG8_MMA(1, 1, At, B1); PG8_BAR;
            }
        }
        if constexpr (ALIGN_EPI) { if (wr == 0) PG8_BAR; }
        if constexpr (!Epi::AFTER_DRAIN) { E(acc, cur, wr, wc, fr, fq); S.done(cur); }
        if (!has_next) break;
#pragma unroll
        for (int a = 0; a < 2; ++a)
#pragma unroll
            for (int b = 0; b < 2; ++b)
#pragma unroll
                for (int m = 0; m < 4; ++m)
#pragma unroll
                    for (int n = 0; n < 2; ++n) acc[a][b][m][n] = (f32x4){0.f, 0.f, 0.f, 0.f};
        cur = nxt; cA = nA; cB = nB; ++ui;
        if constexpr (ALIGN_EPI) { if (wr == 1) PG8_BAR; }
    }
    PG8_WAIT_V(0);
    if constexpr (!ALIGN_EPI) { if (wr == 0) PG8_BAR; }
    PG8_BAR;
    if constexpr (Epi::AFTER_DRAIN) { E.fused(acc, cur, wr, wc, fr, fq, lds, wid, lane); S.done(cur); }
#undef PG8_SA
#undef PG8_SB
#undef PG8_STAGE
#undef PG8_LDA
#undef PG8_LDB
#undef PG8_MMA
#undef PG8_WAIT_V
#undef PG8_WAIT_L
#undef PG8_BAR
#undef PG8_SCHED
}
}
#define GAS __attribute__((address_space(1)))
#define LAS __attribute__((address_space(3)))
typedef unsigned short bf16;
typedef unsigned v4u __attribute__((ext_vector_type(4)));
typedef float f32x4 __attribute__((ext_vector_type(4)));
typedef short bf16x8 __attribute__((ext_vector_type(8)));
typedef GAS unsigned gu32;
typedef GAS unsigned long long gu64;
#define RLX_AGENT __ATOMIC_RELAXED, __HIP_MEMORY_SCOPE_AGENT
#define LDS_WAIT() asm volatile("s_waitcnt lgkmcnt(0)" ::: "memory")
#define VM_WAIT() asm volatile("s_waitcnt vmcnt(0)" ::: "memory")
__device__ __forceinline__ unsigned long long rt() { return __builtin_amdgcn_s_memrealtime(); }
__device__ __forceinline__ unsigned f2bf(float f) { unsigned u = __builtin_bit_cast(unsigned, f); return (u + 0x7fffu + ((u >> 16) & 1u)) >> 16; }
typedef __bf16 hwbf2 __attribute__((ext_vector_type(2))); typedef float hwf2 __attribute__((ext_vector_type(2)));
__device__ __forceinline__ unsigned pk2(float lo, float hi) { hwf2 v = {lo, hi}; hwbf2 r = __builtin_convertvector(v, hwbf2); return __builtin_bit_cast(unsigned, r); }

#define XB_TMO      128
#define XB_XCNT(j)  (256  + 64 * (j))
#define XB_XSUB(j)  (1280 + 64 * (j))
#define XB_XGEN(j)  (2304 + 64 * (j))
#define XB_TOP      3328
#define XB_TOPGEN   3392
#define XCD_BAR_WORDS 3456
#define XB_SPIN_CAP (1u << 18)

__device__ __forceinline__ unsigned xb_ld(unsigned* p)              { return __hip_atomic_load(p, __ATOMIC_RELAXED, __HIP_MEMORY_SCOPE_AGENT); }
__device__ __forceinline__ unsigned xb_add(unsigned* p, unsigned v) { return __hip_atomic_fetch_add(p, v, __ATOMIC_RELAXED, __HIP_MEMORY_SCOPE_AGENT); }
__device__ __forceinline__ unsigned xb_xcc_id() { return (unsigned)__builtin_amdgcn_s_getreg((3 << 11) | 20) & 0xFu; }
#define XB_SPIN(cond, bar) do { unsigned _sp = 0; while (cond) { __builtin_amdgcn_s_sleep(1); \
    if ((++_sp & 255u) == 0u) { if (xb_ld(&(bar)[XB_TMO])) break; if (_sp > XB_SPIN_CAP) { atomicAdd(&(bar)[XB_TMO], 1u); break; } } } } while (0)

struct XcdBarrier {
    unsigned* bar; unsigned x;
    volatile LAS unsigned* st;
};

__device__ __forceinline__ XcdBarrier xcd_barrier_post(unsigned* bar, volatile LAS unsigned* st) {
    XcdBarrier b; b.bar = bar; b.x = xb_xcc_id(); b.st = st;
    if (threadIdx.x == 0) (void)xb_add(&bar[XB_XCNT(b.x)], 1u);
    return b;
}
__device__ __forceinline__ void xcd_barrier_complete(unsigned* bar, unsigned x, unsigned& nloc, unsigned& nx) {
    const unsigned G = gridDim.x * gridDim.y * gridDim.z;
    unsigned sum, cnt, mine, sp = 0u;
    for (;;) {
        sum = 0u; cnt = 0u; mine = 0u;
#pragma unroll
        for (unsigned j = 0; j < 16; ++j) { const unsigned c = xb_ld(&bar[XB_XCNT(j)]); sum += c; cnt += (c > 0u) ? 1u : 0u; mine = (j == x) ? c : mine; }
        if (sum == G) break;
        __builtin_amdgcn_s_sleep(1);
        if ((++sp & 255u) == 0u) { if (xb_ld(&bar[XB_TMO])) break; if (sp > XB_SPIN_CAP) { atomicAdd(&bar[XB_TMO], 1u); break; } }
    }
    nloc = mine > 0u ? mine : 1u; nx = cnt > 0u ? cnt : 1u;
}

__device__ __forceinline__ void xcd_barrier(const XcdBarrier& b) {
    asm volatile("s_waitcnt vmcnt(0)" ::: "memory");
    __syncthreads();
    if (threadIdx.x == 0) {
        unsigned* bar = b.bar;
        __builtin_amdgcn_s_waitcnt(0);
        unsigned nloc = b.st[0], nx = b.st[1];
        if (nloc == 0u) { xcd_barrier_complete(bar, b.x, nloc, nx); b.st[0] = nloc; b.st[1] = nx; }
        const unsigned old = xb_add(&bar[XB_XSUB(b.x)], 1u);
        const unsigned gen = old / nloc;
        if (old + 1u == (gen + 1u) * nloc) {
            __builtin_amdgcn_fence(__ATOMIC_RELEASE, "agent");
            asm volatile("s_waitcnt vmcnt(0)" ::: "memory");
            const unsigned og = xb_add(&bar[XB_TOP], 1u);
            const unsigned tg = og / nx;
            if (og + 1u == (tg + 1u) * nx) xb_add(&bar[XB_TOPGEN], 1u);
            else XB_SPIN(xb_ld(&bar[XB_TOPGEN]) == tg, bar);
            __builtin_amdgcn_fence(__ATOMIC_ACQUIRE, "agent");
            xb_add(&bar[XB_XGEN(b.x)], 1u);
            asm volatile("s_waitcnt vmcnt(0)" ::: "memory");
        } else {
            XB_SPIN(xb_ld(&bar[XB_XGEN(b.x)]) == gen, bar);
            __builtin_amdgcn_fence(__ATOMIC_ACQUIRE, "agent");
            asm volatile("s_waitcnt vmcnt(0)" ::: "memory");
        }
    }
    __syncthreads();
}
#ifdef ASMPK
#define EPK pg8::cvt_pk_bf16
#else
#define EPK pk2
#endif
typedef unsigned v2u __attribute__((ext_vector_type(2)));
typedef float f32x16 __attribute__((ext_vector_type(16)));
typedef short s16x4 __attribute__((ext_vector_type(4)));
__device__ __forceinline__ float bflo(unsigned u) { return __builtin_bit_cast(float, u << 16); }
__device__ __forceinline__ float bfhi(unsigned u) { return __builtin_bit_cast(float, u & 0xffff0000u); }
__device__ __forceinline__ float wave_sum(float v) {
#pragma unroll
    for (int o = 1; o < 64; o <<= 1) v += __shfl_xor(v, o);
    return v;
}

constexpr int NTOK = 16384, SEQ = 8192, DM = 4096, NIN = 10816, NINP = 11008, DFF = 16384, PLE = 256, NWAVES = 8;
constexpr int C_AQ = 0, C_AK = 1024, C_AV = 2048, C_BQ = 3072, C_BK = 4096, C_BV = 5120, C_CQ = 6144, C_CKV = 7168, C_CKR = 7680, C_DQ = 7744, C_DK = 8768, C_DV = 9792;
constexpr float LN_EPS = 1e-5f, RMS_EPS = 1e-6f, DN_ALPHA = 1.41421356237f;
constexpr size_t MiB = 1u << 20;
constexpr size_t WS_CTL = 0, CTL_ZERO_BYTES = 1 * MiB;
constexpr size_t WS_COS128 = 2 * MiB, WS_SIN128 = 4 * MiB, WS_COS64 = 6 * MiB, WS_SIN64 = 7 * MiB;
constexpr size_t WS_RSQ = 8 * MiB, WS_RSKV = 8 * MiB + 65536, WS_LSE = 9 * MiB;
constexpr size_t WS_WIN = 16 * MiB, WS_WO = 102 * MiB, WS_FF1 = 134 * MiB, WS_FF2 = 262 * MiB, WS_GATE = 390 * MiB, WS_PROJ = 422 * MiB, WS_UQ = 424 * MiB, WS_UKV = 427 * MiB;
constexpr size_t WS_XB = 430 * MiB, WS_H = 558 * MiB, WS_DP = 902 * MiB, WS_DO = 998 * MiB, WS_MIX = 1070 * MiB, WS_QM = 1198 * MiB, WS_KVM = 1246 * MiB, WS_Y = 1310 * MiB, WS_PB = 1566 * MiB, WS_END = 1574 * MiB;
constexpr int CW_BAR = 4096, CW_Q = 8192;
constexpr int RING_BYTES = 131072, MISC_OFF = RING_BYTES + 320, LDS_BYTES = 147456;

struct Args { const float* in[20]; float* out; unsigned char* ws; int L, pad; };

template <int ACT  > struct EpiB {
    static constexpr bool PERM = true, AFTER_DRAIN = false;
    bf16* O; int ldc; const float* rowscale;
    __device__ __forceinline__ void operator()(const pg8::f32x4 (&acc)[2][2][4][2], const pg8::Unit& u, int wr, int wc, int fr, int fq) const {
        const int row0 = u.pm * 256 + wr * 64 + fr, col0 = u.pn * 256 + wc * 32 + 8 * fq;
#pragma unroll
        for (int ai = 0; ai < 2; ++ai)
#pragma unroll
            for (int m = 0; m < 4; ++m) { const int row = row0 + ai * 128 + m * 16; bf16* rowp = O + (size_t)row * ldc + col0;
                const float rs = rowscale ? rowscale[row] : 1.f;
#pragma unroll
                for (int bj = 0; bj < 2; ++bj) { pg8::f32x4 v0 = acc[ai][bj][m][0], v1 = acc[ai][bj][m][1];
                    if (ACT == 2) {
#pragma unroll
                        for (int e = 0; e < 4; ++e) { float a = v0[e] > 0.f ? v0[e] : 0.f; v0[e] = a * a; float b = v1[e] > 0.f ? v1[e] : 0.f; v1[e] = b * b; } }
                    v0 = v0 * rs; v1 = v1 * rs;
                    v4u w; w.x = EPK(v0[0], v0[1]); w.y = EPK(v0[2], v0[3]); w.z = EPK(v1[0], v1[1]); w.w = EPK(v1[2], v1[3]);
                    *(v4u*)(rowp + bj * 128) = w; } }
    }
};
template <int GATE  > struct EpiF {
    static constexpr bool PERM = true, AFTER_DRAIN = false;
    float* O; const float* G; int ldc;
    __device__ __forceinline__ void operator()(const pg8::f32x4 (&acc)[2][2][4][2], const pg8::Unit& u, int wr, int wc, int fr, int fq) const {
        const int row0 = u.pm * 256 + wr * 64 + fr, col0 = u.pn * 256 + wc * 32 + 8 * fq;
#pragma unroll
        for (int ai = 0; ai < 2; ++ai)
#pragma unroll
            for (int m = 0; m < 4; ++m) { const size_t off = (size_t)(row0 + ai * 128 + m * 16) * ldc + col0;
#pragma unroll
                for (int bj = 0; bj < 2; ++bj) { pg8::f32x4 v0 = acc[ai][bj][m][0], v1 = acc[ai][bj][m][1];
                    if (GATE) { const pg8::f32x4 g0 = *(const pg8::f32x4*)(G + off + bj * 128), g1 = *(const pg8::f32x4*)(G + off + bj * 128 + 4);
#pragma unroll
                        for (int e = 0; e < 4; ++e) { v0[e] = g0[e] / (1.f + __expf(-v0[e])); v1[e] = g1[e] / (1.f + __expf(-v1[e])); } }
                    *(pg8::f32x4*)(O + off + bj * 128) = v0; *(pg8::f32x4*)(O + off + bj * 128 + 4) = v1; } }
    }
};

struct EpiG {
    static constexpr bool PERM = true, AFTER_DRAIN = false;
    bf16* O; const bf16* G; int ldc;
    __device__ __forceinline__ void operator()(const pg8::f32x4 (&acc)[2][2][4][2], const pg8::Unit& u, int wr, int wc, int fr, int fq) const {
        const int row0 = u.pm * 256 + wr * 64 + fr, col0 = u.pn * 256 + wc * 32 + 8 * fq;
#pragma unroll
        for (int ai = 0; ai < 2; ++ai)
#pragma unroll
            for (int m = 0; m < 4; ++m) { const size_t off = (size_t)(row0 + ai * 128 + m * 16) * ldc + col0;
#pragma unroll
                for (int bj = 0; bj < 2; ++bj) { const pg8::f32x4 v0 = acc[ai][bj][m][0], v1 = acc[ai][bj][m][1]; const v4u g = *(const v4u*)(G + off + bj * 128);
                    float o[8];
#pragma unroll
                    for (int e = 0; e < 4; ++e) { const float a = e < 2 ? v0[2 * e] : v1[2 * e - 4], b = e < 2 ? v0[2 * e + 1] : v1[2 * e - 3];
                        o[2 * e] = bflo(g[e]) / (1.f + __expf(-a)); o[2 * e + 1] = bfhi(g[e]) / (1.f + __expf(-b)); }
                    v4u w; w.x = pk2(o[0], o[1]); w.y = pk2(o[2], o[3]); w.z = pk2(o[4], o[5]); w.w = pk2(o[6], o[7]);
                    *(v4u*)(O + off + bj * 128) = w; } }
    }
};
__device__ __forceinline__ void transpose_item(const float* W, int K, int N, bf16* WT, const float* ks, LAS float* scr, int item, int lane) {
    const int nblk = N / 32, kb = item / nblk, nb = item % nblk, k0 = 64 * kb, n0 = 32 * nb;
    float tv[32];
#pragma unroll
    for (int i = 0; i < 32; ++i) { const int kk = 2 * i + (lane >> 5); tv[i] = W[(size_t)(k0 + kk) * N + n0 + (lane & 31)]; }
#pragma unroll
    for (int i = 0; i < 32; ++i) { const int kk = 2 * i + (lane >> 5); float v = tv[i]; if (ks) v *= ks[k0 + kk]; scr[kk * 33 + (lane & 31)] = v; }
    LDS_WAIT(); asm volatile("" ::: "memory");
    const int c = lane & 7;
#pragma unroll
    for (int j = 0; j < 4; ++j) { const int n = (lane >> 3) + 8 * j; const LAS float* s = scr + (8 * c) * 33 + n;
        v4u o; o.x = pk2(s[0 * 33], s[1 * 33]); o.y = pk2(s[2 * 33], s[3 * 33]); o.z = pk2(s[4 * 33], s[5 * 33]); o.w = pk2(s[6 * 33], s[7 * 33]);
        *(v4u*)(WT + (size_t)(n0 + n) * K + k0 + 8 * c) = o; }
    LDS_WAIT(); asm volatile("" ::: "memory");
}
__device__ __forceinline__ void cvt_rows(const float* src, bf16* dst, size_t n8, size_t gtid, size_t gthreads) {
    for (size_t i = gtid; i < n8; i += gthreads) { const f32x4 a = *(const f32x4*)(src + i * 8), b = *(const f32x4*)(src + i * 8 + 4);
        v4u w; w.x = pk2(a[0], a[1]); w.y = pk2(a[2], a[3]); w.z = pk2(b[0], b[1]); w.w = pk2(b[2], b[3]); *(v4u*)(dst + i * 8) = w; }
}

__device__ __forceinline__ void ln_rows(const float* xs, const bf16* y, const float* g, const float* b, float* xo, bf16* xb, int gw, int ngw, int lane) {
    for (int r = gw; r < NTOK; r += ngw) {
        const f32x4* xr = (const f32x4*)(xs + (size_t)r * DM) + lane; const v2u* yr = (const v2u*)(y + (size_t)r * DM) + lane;
        f32x4 v[16]; float s = 0.f;
#pragma unroll
        for (int j = 0; j < 16; ++j) { const f32x4 a = xr[64 * j]; const v2u cw = yr[64 * j]; const f32x4 c = {bflo(cw.x), bfhi(cw.x), bflo(cw.y), bfhi(cw.y)}; v[j] = a * DN_ALPHA + c; s += (v[j][0] + v[j][1]) + (v[j][2] + v[j][3]); }
        const float mean = wave_sum(s) * (1.f / DM); float s2 = 0.f;
#pragma unroll
        for (int j = 0; j < 16; ++j) { v[j] = v[j] - mean; s2 += (v[j][0] * v[j][0] + v[j][1] * v[j][1]) + (v[j][2] * v[j][2] + v[j][3] * v[j][3]); }
        const float rstd = 1.f / sqrtf(wave_sum(s2) * (1.f / DM) + LN_EPS);
        f32x4* orow = (f32x4*)(xo + (size_t)r * DM) + lane; v2u* brow = (v2u*)(xb + (size_t)r * DM) + lane;
#pragma unroll
        for (int j = 0; j < 16; ++j) { const f32x4 gg = ((const f32x4*)g)[lane + 64 * j], bb = ((const f32x4*)b)[lane + 64 * j]; const f32x4 o = v[j] * rstd * gg + bb;
            orow[64 * j] = o; v2u w; w.x = pk2(o[0], o[1]); w.y = pk2(o[2], o[3]); brow[64 * j] = w; }
    }
}

__device__ __forceinline__ void rope8(bf16* p1, bf16* p2, const float* cs, const float* sn) {
    const v4u a = *(const v4u*)p1, b = *(const v4u*)p2; const f32x4 c0 = *(const f32x4*)cs, c1 = *(const f32x4*)(cs + 4), s0 = *(const f32x4*)sn, s1 = *(const f32x4*)(sn + 4);
    float x1[8], x2[8], c[8], s[8];
#pragma unroll
    for (int e = 0; e < 4; ++e) { x1[2 * e] = bflo(a[e]); x1[2 * e + 1] = bfhi(a[e]); x2[2 * e] = bflo(b[e]); x2[2 * e + 1] = bfhi(b[e]); c[e] = c0[e]; c[e + 4] = c1[e]; s[e] = s0[e]; s[e + 4] = s1[e]; }
    v4u oa, ob;
#pragma unroll
    for (int e = 0; e < 4; ++e) {
        const float y1a = x1[2 * e] * c[2 * e] - x2[2 * e] * s[2 * e], y1b = x1[2 * e + 1] * c[2 * e + 1] - x2[2 * e + 1] * s[2 * e + 1];
        const float y2a = x2[2 * e] * c[2 * e] + x1[2 * e] * s[2 * e], y2b = x2[2 * e + 1] * c[2 * e + 1] + x1[2 * e + 1] * s[2 * e + 1];
        oa[e] = pk2(y1a, y1b); ob[e] = pk2(y2a, y2b); }
    *(v4u*)p1 = oa; *(v4u*)p2 = ob;
}
__device__ __forceinline__ float sumsq8(const bf16* p) { const v4u a = *(const v4u*)p; float s = 0.f;
#pragma unroll
    for (int e = 0; e < 4; ++e) { const float lo = bflo(a[e]), hi = bfhi(a[e]); s += lo * lo + hi * hi; } return s; }
__device__ __forceinline__ void rope_rows(bf16* H, const float* cos128, const float* sin128, const float* cos64, const float* sin64, float* rsq, float* rskv, int gw, int ngw, int lane) {
    for (int r = gw; r < NTOK; r += ngw) {
        bf16* hr = H + (size_t)r * NINP; const int pos = r % SEQ;
        const int j0 = 8 * (lane & 7), hd = lane >> 3;
#pragma unroll
        for (int it = 0; it < 4; ++it) {
            const int head = hd + 8 * it; bf16* base = hr + (head < 16 ? C_BQ + head * 128 : C_DQ + (head - 16) * 128) + j0;
            rope8(base, base + 64, cos128 + (size_t)pos * 64 + j0, sin128 + (size_t)pos * 64 + j0); }
        if (lane < 4) rope8(hr + C_CKR + 8 * lane, hr + C_CKR + 32 + 8 * lane, cos64 + (size_t)pos * 32 + 8 * lane, sin64 + (size_t)pos * 32 + 8 * lane);
        float sq = sumsq8(hr + C_CQ + 8 * lane) + sumsq8(hr + C_CQ + 512 + 8 * lane); float skv = sumsq8(hr + C_CKV + 8 * lane);
        sq = wave_sum(sq); skv = wave_sum(skv);
        if (lane == 0) { rsq[r] = 1.f / sqrtf(sq * (1.f / 1024.f) + RMS_EPS); rskv[r] = 1.f / sqrtf(skv * (1.f / 512.f) + RMS_EPS); }
    }
}

__device__ __forceinline__ void combine_rows(const bf16* DP, const float* LSE, const bf16* DO, const float* lamp, const float* subln, float lam_init, bf16* MIX, int gw, int ngw, int lane) {
    float d0 = lamp[lane] * lamp[128 + lane] + lamp[64 + lane] * lamp[192 + lane], d1 = lamp[256 + lane] * lamp[384 + lane] + lamp[320 + lane] * lamp[448 + lane];
    d0 = wave_sum(d0); d1 = wave_sum(d1);
    const float lam = __expf(d0) - __expf(d1) + lam_init, post = 1.f - lam_init;
    for (int r = gw; r < NTOK; r += ngw) {
#pragma unroll
        for (int i = 0; i < 2; ++i) {
            const int col = 8 * (lane + 64 * i), hd = col >> 7;
            const float l0 = LSE[(size_t)r * 8 + hd], l1 = LSE[(size_t)(NTOK + r) * 8 + hd], l2 = LSE[(size_t)(2 * NTOK + r) * 8 + hd];
            const float mx = fmaxf(l0, fmaxf(l1, l2)); float w0 = __expf(l0 - mx), w1 = __expf(l1 - mx), w2 = __expf(l2 - mx); const float inv = 1.f / (w0 + w1 + w2); w0 *= inv; w1 *= inv; w2 *= inv;
            const v4u a = *(const v4u*)(DP + (size_t)r * 1024 + col), b = *(const v4u*)(DP + ((size_t)NTOK + r) * 1024 + col), c = *(const v4u*)(DP + ((size_t)2 * NTOK + r) * 1024 + col);
            v4u o;
#pragma unroll
            for (int e = 0; e < 4; ++e) o[e] = pk2(w0 * bflo(a[e]) + w1 * bflo(b[e]) + w2 * bflo(c[e]), w0 * bfhi(a[e]) + w1 * bfhi(b[e]) + w2 * bfhi(c[e]));
            *(v4u*)(MIX + (size_t)r * DM + 1024 + col) = o; }
#pragma unroll
        for (int i = 0; i < 2; ++i) {
            const int col = 8 * (lane + 64 * i), dcol = col & 255;
            const v4u a = *(const v4u*)(DO + (size_t)r * 1024 + col), b = *(const v4u*)(DO + ((size_t)NTOK + r) * 1024 + col);
            float v[8]; float ss = 0.f;
#pragma unroll
            for (int e = 0; e < 4; ++e) { v[2 * e] = bflo(a[e]) - lam * bflo(b[e]); v[2 * e + 1] = bfhi(a[e]) - lam * bfhi(b[e]); ss += v[2 * e] * v[2 * e] + v[2 * e + 1] * v[2 * e + 1]; }
#pragma unroll
            for (int o = 1; o < 32; o <<= 1) ss += __shfl_xor(ss, o);
            const float rs = post / sqrtf(ss * (1.f / 256.f) + RMS_EPS);
            const f32x4 g0 = *(const f32x4*)(subln + dcol), g1 = *(const f32x4*)(subln + dcol + 4);
            v4u o; o.x = pk2(v[0] * rs * g0[0], v[1] * rs * g0[1]); o.y = pk2(v[2] * rs * g0[2], v[3] * rs * g0[3]); o.z = pk2(v[4] * rs * g1[0], v[5] * rs * g1[1]); o.w = pk2(v[6] * rs * g1[2], v[7] * rs * g1[3]);
            *(v4u*)(MIX + (size_t)r * DM + 3072 + col) = o; }
    }
}
struct AttnDesc {
    const bf16* Q; const bf16* K; const bf16* K2; const bf16* V; bf16* O; float* LSE; const float* cosT; const float* sinT;
    int ldq, ldk, ldk2, ldv, ldo, lse_ld;
    int row0, rstride, iq0, W, pos0; float scale;
};
#define MFMA32(a, b, c) __builtin_amdgcn_mfma_f32_32x32x16_bf16((a), (b), (c), 0, 0, 0)
__device__ __forceinline__ bf16x8 pack8(const f32x16& x, int s) {
    v4u p; p.x = pk2(x[8 * s], x[8 * s + 1]); p.y = pk2(x[8 * s + 2], x[8 * s + 3]); p.z = pk2(x[8 * s + 4], x[8 * s + 5]); p.w = pk2(x[8 * s + 6], x[8 * s + 7]);
    return __builtin_bit_cast(bf16x8, p);
}
constexpr float LOG2E = 1.44269504089f, LN2 = 0.69314718056f;

template <int DK, int MODE  , bool ROPEQ>
__device__ __forceinline__ void attn_unit(LAS unsigned char* lds, const AttnDesc& d, int tid, int wid, int lane) {
    constexpr int NKC = DK / 16, KS = DK * 2 + 16, VS = 144, NKP = DK / 64, KCH = DK / 8;
    const int n = lane & 31, h = lane >> 5;
    const int iq = d.iq0 + 32 * wid + n;
    const size_t qtok = (size_t)d.row0 + (size_t)iq * d.rstride;
    bf16x8 qf[NKC];
    { const bf16* qrow = d.Q + qtok * d.ldq;
#pragma unroll
      for (int c = 0; c < NKC; ++c) qf[c] = *(const bf16x8*)(qrow + 16 * c + 8 * h); }
    if constexpr (ROPEQ) {
        const int pos = d.pos0 + iq * d.rstride;
#pragma unroll
        for (int cc = 0; cc < 2; ++cc) { const int j0 = 16 * cc + 8 * h; const float* cp = d.cosT + (size_t)pos * 32 + j0; const float* sp = d.sinT + (size_t)pos * 32 + j0;
            const v4u a = __builtin_bit_cast(v4u, qf[8 + cc]), b = __builtin_bit_cast(v4u, qf[10 + cc]); v4u oa, ob;
#pragma unroll
            for (int e = 0; e < 4; ++e) { const float c0 = cp[2 * e], c1 = cp[2 * e + 1], s0 = sp[2 * e], s1 = sp[2 * e + 1];
                const float x1a = bflo(a[e]), x1b = bfhi(a[e]), x2a = bflo(b[e]), x2b = bfhi(b[e]);
                oa[e] = pk2(x1a * c0 - x2a * s0, x1b * c1 - x2b * s1); ob[e] = pk2(x2a * c0 + x1a * s0, x2b * c1 + x1b * s1); }
            qf[8 + cc] = __builtin_bit_cast(bf16x8, oa); qf[10 + cc] = __builtin_bit_cast(bf16x8, ob); }
    }
    const int jhi = d.iq0 / 64 + 3; int lo_key = d.iq0 - d.W; if (lo_key < 0) lo_key = 0; const int jlo = lo_key / 64;
    const int wq_min = d.iq0 + 32 * wid, wq_max = wq_min + 31;
    f32x16 o[4];
#pragma unroll
    for (int s = 0; s < 4; ++s)
#pragma unroll
        for (int e = 0; e < 16; ++e) o[s][e] = 0.f;
    float m_run = -INFINITY, l_run = 0.f, carry = 0.f;
    const float sc2 = d.scale * LOG2E;
    v4u kreg[NKP], vreg[2];
    const int vkey = tid & 63, vch0 = tid >> 6; const int vpos = (vkey & ~12) | ((vkey & 4) << 1) | ((vkey & 8) >> 1);
#define ATT_PREFETCH(j) do { \
        _Pragma("unroll") for (int i = 0; i < NKP; ++i) { const int p = tid + 512 * i, key = p / KCH, ch = p % KCH; const size_t tok = (size_t)d.row0 + (size_t)(64 * (j) + key) * d.rstride; \
            const bf16* src = (DK == 192 && ch >= 16) ? d.K2 + tok * d.ldk2 + (ch - 16) * 8 : d.K + tok * d.ldk + ch * 8; kreg[i] = *(const v4u*)src; } \
        { const size_t tok = (size_t)d.row0 + (size_t)(64 * (j) + vkey) * d.rstride; const bf16* src = d.V + tok * d.ldv; \
          vreg[0] = *(const v4u*)(src + vch0 * 8); vreg[1] = *(const v4u*)(src + (vch0 + 8) * 8); } } while (0)
#define ATT_WRITE(BUFOFF) do { LAS unsigned char* wK = lds + (BUFOFF); LAS unsigned char* wV = wK + 64 * KS; \
        _Pragma("unroll") for (int i = 0; i < NKP; ++i) { const int p = tid + 512 * i, key = p / KCH, ch = p % KCH; *(LAS v4u*)(wK + key * KS + ch * 16) = kreg[i]; } \
        _Pragma("unroll") for (int i = 0; i < 2; ++i) { const int dv0 = (vch0 + 8 * i) * 8; \
            _Pragma("unroll") for (int e = 0; e < 4; ++e) { *(LAS unsigned short*)(wV + (dv0 + 2 * e) * VS + vpos * 2) = (unsigned short)(vreg[i][e] & 0xffffu); *(LAS unsigned short*)(wV + (dv0 + 2 * e + 1) * VS + vpos * 2) = (unsigned short)(vreg[i][e] >> 16); } } } while (0)
#define ATT_COMPUTE(BUFOFF) do { LAS unsigned char* ldsK = lds + (BUFOFF); LAS unsigned char* ldsV = ldsK + 64 * KS; const int k0 = 64 * j; \
        if (!(k0 > wq_max || (wq_min - (k0 + 63)) > d.W)) { \
        f32x16 s0, s1; \
_Pragma("unroll") \
        for (int e = 0; e < 16; ++e) { s0[e] = 0.f; s1[e] = 0.f; } \
        __builtin_amdgcn_s_setprio(1); \
_Pragma("unroll") \
        for (int c = 0; c < NKC; ++c) { \
            const bf16x8 a0 = *(const LAS bf16x8*)(ldsK + n * KS + c * 32 + h * 16), a1 = *(const LAS bf16x8*)(ldsK + (32 + n) * KS + c * 32 + h * 16); \
            s0 = MFMA32(a0, qf[c], s0); s1 = MFMA32(a1, qf[c], s1); } \
        __builtin_amdgcn_s_setprio(0); \
        const bool full = (k0 + 63 <= wq_min - MODE) && (wq_max - k0 <= d.W); \
        if constexpr (MODE == 0) { \
            if (!full) { \
_Pragma("unroll") \
                for (int e = 0; e < 16; ++e) { const int ik = k0 + (e & 3) + 8 * (e >> 2) + 4 * h; const int dd0 = iq - ik, dd1 = dd0 - 32; \
                    if (dd0 < 0 || dd0 > d.W) s0[e] = -INFINITY; if (dd1 < 0 || dd1 > d.W) s1[e] = -INFINITY; } } \
            float mx = fmaxf(s0[0], s1[0]); \
_Pragma("unroll") \
            for (int e = 1; e < 16; ++e) mx = fmaxf(mx, fmaxf(s0[e], s1[e])); \
            mx = fmaxf(mx, __shfl_xor(mx, 32)); \
            const float m_new = fmaxf(m_run, mx); \
            const float msafe = (m_new == -INFINITY) ? 0.f : m_new; \
            const float mb = msafe * sc2; \
            const float alpha = __builtin_amdgcn_exp2f((m_run - msafe) * sc2); \
            float rs = 0.f; \
_Pragma("unroll") \
            for (int e = 0; e < 16; ++e) { s0[e] = __builtin_amdgcn_exp2f(__builtin_fmaf(s0[e], sc2, -mb)); s1[e] = __builtin_amdgcn_exp2f(__builtin_fmaf(s1[e], sc2, -mb)); rs += s0[e] + s1[e]; } \
            l_run = l_run * alpha + rs; m_run = m_new; \
            if (__builtin_amdgcn_ballot_w64(alpha != 1.f) != 0ull) { \
_Pragma("unroll") \
                for (int s = 0; s < 4; ++s) \
_Pragma("unroll") \
                    for (int e = 0; e < 16; ++e) o[s][e] *= alpha; } \
        } else { \
            const float sc = d.scale; \
_Pragma("unroll") \
            for (int t = 1; t >= 0; --t) { \
                f32x16& S = t ? s1 : s0; float l1m[16]; float g[4], pg[4]; \
_Pragma("unroll") \
                for (int e = 0; e < 16; ++e) { const int ik = k0 + 32 * t + (e & 3) + 8 * (e >> 2) + 4 * h; const bool valid = full || (ik < iq); \
                    const float z = S[e] * sc2; const float lp = __builtin_amdgcn_logf(1.f + __builtin_amdgcn_exp2f(-fabsf(z))); \
                    const float lb = fminf(z, 0.f) - lp; \
                    l1m[e] = valid ? (lb - z) : 0.f; \
                    S[e] = valid ? lb : -INFINITY; } \
_Pragma("unroll") \
                for (int i = 0; i < 4; ++i) { g[i] = (l1m[4 * i] + l1m[4 * i + 1]) + (l1m[4 * i + 2] + l1m[4 * i + 3]); pg[i] = __shfl_xor(g[i], 32); } \
                float run = carry; \
_Pragma("unroll") \
                for (int i = 3; i >= 0; --i) { float acc = run + (h == 0 ? pg[i] : 0.f); \
_Pragma("unroll") \
                    for (int jj = 3; jj >= 0; --jj) { const int e = 4 * i + jj; S[e] = __builtin_amdgcn_exp2f(S[e] + acc); acc += l1m[e]; } \
                    run += g[i] + pg[i]; } \
                carry = run; \
            } \
        } \
        bf16x8 pf[2][2]; \
        pf[0][0] = pack8(s0, 0); pf[0][1] = pack8(s0, 1); pf[1][0] = pack8(s1, 0); pf[1][1] = pack8(s1, 1); \
        __builtin_amdgcn_s_setprio(1); \
_Pragma("unroll") \
        for (int s = 0; s < 4; ++s) \
_Pragma("unroll") \
            for (int t = 0; t < 2; ++t) \
_Pragma("unroll") \
                for (int c = 0; c < 2; ++c) { const LAS unsigned char* vp = ldsV + (32 * s + n) * VS + (32 * t + 16 * c + 8 * h) * 2; \
                    const bf16x8 vf = *(const LAS bf16x8*)vp; \
                     \
                    o[s] = MFMA32(vf, pf[t][c], o[s]); } \
        __builtin_amdgcn_s_setprio(0); \
        } } while (0)
    ATT_PREFETCH(jhi); ATT_WRITE(0); __syncthreads();
    for (int j = jhi;;) {
        if (j > jlo) ATT_PREFETCH(j - 1);
        ATT_COMPUTE(0);
        if (j > jlo) ATT_WRITE(49152);
        __syncthreads();
        if (j == jlo) break; --j;
        if (j > jlo) ATT_PREFETCH(j - 1);
        ATT_COMPUTE(49152);
        if (j > jlo) ATT_WRITE(0);
        __syncthreads();
        if (j == jlo) break; --j;
    }
#undef ATT_PREFETCH
#undef ATT_WRITE
#undef ATT_COMPUTE
    float inv = 1.f;
    if constexpr (MODE == 0) { const float l = l_run + __shfl_xor(l_run, 32); inv = 1.f / l;
        if (d.LSE && h == 0) d.LSE[qtok * d.lse_ld] = (m_run * sc2 + __builtin_amdgcn_logf(l)) * LN2; }
    bf16* orow = d.O + qtok * d.ldo;
#pragma unroll
    for (int s = 0; s < 4; ++s)
#pragma unroll
        for (int i = 0; i < 4; ++i) { v2u w; w.x = pk2(o[s][4 * i] * inv, o[s][4 * i + 1] * inv); w.y = pk2(o[s][4 * i + 2] * inv, o[s][4 * i + 3] * inv);
            *(v2u*)(orow + 32 * s + 8 * i + 4 * h) = w; }
}

#define PHL unsigned char* wsl = args.ws; asm volatile("" : "+s"(wsl)); int tid = threadIdx.x; asm volatile("" : "+v"(tid)); const int lane = tid & 63, wave = __builtin_amdgcn_readfirstlane(tid >> 6); const int G = gridDim.x, gw = blockIdx.x * NWAVES + wave, ngw = G * NWAVES; (void)lane; (void)gw; (void)ngw; (void)G
#define WP(T, off) ((T*)(wsl + (off)))
#define PH_ON(k) if constexpr (PH < 0 || PH == (k))
#define GRIDBAR() do { if constexpr (PH < 0) xcd_barrier(bar); } while (0)
#define ONE_LAUNCH 1
#if ONE_LAUNCH
__global__ void __launch_bounds__(512, 2) hybrid_one(Args args) {

    extern __shared__ __attribute__((aligned(16))) unsigned char lds_raw[];
    LAS unsigned char* lds = (LAS unsigned char*)lds_raw;
    volatile LAS unsigned* MISC = (volatile LAS unsigned*)(lds + MISC_OFF);
    for (int u = threadIdx.x; u < (LDS_BYTES - RING_BYTES) / 4; u += 512) ((LAS unsigned*)(lds + RING_BYTES))[u] = 0u;
    __syncthreads();

    XcdBarrier bar = xcd_barrier_post((unsigned*)((gu32*)(args.ws + WS_CTL) + CW_BAR), MISC + 8);
    { constexpr int L = 0; constexpr int PH = -1;

        PH_ON(0) {
            PHL; const size_t gtid = (size_t)blockIdx.x * 512 + tid, gthreads = (size_t)G * 512;
            LAS float* scr = (LAS float*)(lds + wave * 16384);
            constexpr int I_IN = 64 * (NIN / 32), I_O = 64 * 128, I_UQ = 16 * 48, I_UKV = 8 * 64, I_F1 = 64 * 512, I_F2 = 256 * 128, I_G = 64 * 128, I_P = 4 * 128;
            constexpr int NITEMS = I_IN + I_O + I_UQ + I_UKV + I_F1 + I_F2 + I_G + I_P;
            for (int it = gw; it < NITEMS; it += ngw) {
                int r = it;
                if (r < I_IN) { transpose_item(args.in[2] + (size_t)L * DM * NIN, DM, NIN, WP(bf16, WS_WIN), nullptr, scr, r, lane); continue; } r -= I_IN;
                if (r < I_O) { transpose_item(args.in[3] + (size_t)L * DM * DM, DM, DM, WP(bf16, WS_WO), nullptr, scr, r, lane); continue; } r -= I_O;
                if (r < I_UQ) { transpose_item(args.in[5] + (size_t)L * 1024 * 1536, 1024, 1536, WP(bf16, WS_UQ), args.in[4] + (size_t)L * 1024, scr, r, lane); continue; } r -= I_UQ;
                if (r < I_UKV) { transpose_item(args.in[7] + (size_t)L * 512 * 2048, 512, 2048, WP(bf16, WS_UKV), args.in[6] + (size_t)L * 512, scr, r, lane); continue; } r -= I_UKV;
                if (r < I_F1) { transpose_item(args.in[12] + (size_t)L * DM * DFF, DM, DFF, WP(bf16, WS_FF1), nullptr, scr, r, lane); continue; } r -= I_F1;
                if (r < I_F2) { transpose_item(args.in[13] + (size_t)L * DFF * DM, DFF, DM, WP(bf16, WS_FF2), nullptr, scr, r, lane); continue; } r -= I_F2;
                if (r < I_G) { transpose_item(args.in[16] + (size_t)L * DM * DM, DM, DM, WP(bf16, WS_GATE), nullptr, scr, r, lane); continue; } r -= I_G;
                transpose_item(args.in[17] + (size_t)L * PLE * DM, PLE, DM, WP(bf16, WS_PROJ), nullptr, scr, r, lane);
            }
            { v4u z = {0u, 0u, 0u, 0u}; v4u* pad = (v4u*)(WP(bf16, WS_WIN) + (size_t)NIN * DM); const size_t n16 = (size_t)(NINP - NIN) * DM / 8; for (size_t i = gtid; i < n16; i += gthreads) pad[i] = z; }
            cvt_rows(args.in[1] + (size_t)L * NTOK * PLE, WP(bf16, WS_PB), (size_t)NTOK * PLE / 8, gtid, gthreads);
            if (L == 0) {
                cvt_rows(args.in[0], WP(bf16, WS_XB), (size_t)NTOK * DM / 8, gtid, gthreads);
                float* cos128 = WP(float, WS_COS128); float* sin128 = WP(float, WS_SIN128); float* cos64 = WP(float, WS_COS64); float* sin64 = WP(float, WS_SIN64);
                for (size_t i = gtid; i < (size_t)SEQ * 64; i += gthreads) { const int pos = (int)(i >> 6), j = (int)(i & 63); const float inv = powf(10000.0f, -(float)j / 64.0f); const float ang = (float)pos * inv; cos128[i] = cosf(ang); sin128[i] = sinf(ang); }
                for (size_t i = gtid; i < (size_t)SEQ * 32; i += gthreads) { const int pos = (int)(i >> 5), j = (int)(i & 31); const float inv = powf(10000.0f, -(float)j / 32.0f); const float ang = (float)pos * inv; cos64[i] = cosf(ang); sin64[i] = sinf(ang); }
            }
        }
        GRIDBAR();
        PH_ON(1) { PHL; pg8::Gemm g{WP(bf16, WS_XB), WP(bf16, WS_WIN), NTOK, NINP, DM, DM}; pg8::StaticOrder S; S.init(NTOK, NINP, G, (int)blockIdx.x); EpiB<0> E{WP(bf16, WS_H), NINP, nullptr};
          pg8::gemm_phase<EpiB<0>, pg8::StaticOrder, true, true>(lds, g, S, E); }
        GRIDBAR();
        PH_ON(2) { PHL; rope_rows(WP(bf16, WS_H), WP(float, WS_COS128), WP(float, WS_SIN128), WP(float, WS_COS64), WP(float, WS_SIN64), WP(float, WS_RSQ), WP(float, WS_RSKV), gw, ngw, lane); }
        GRIDBAR();
        PH_ON(3) {
        { PHL; pg8::Gemm g{WP(bf16, WS_H) + C_CQ, WP(bf16, WS_UQ), NTOK, 1536, 1024, NINP}; pg8::StaticOrder S; S.init(NTOK, 1536, G, (int)blockIdx.x); EpiB<0> E{WP(bf16, WS_QM), 1536, WP(float, WS_RSQ)};
          pg8::gemm_phase<EpiB<0>, pg8::StaticOrder, true, true>(lds, g, S, E); }
        __syncthreads();
        { PHL; pg8::Gemm g{WP(bf16, WS_H) + C_CKV, WP(bf16, WS_UKV), NTOK, 2048, 512, NINP}; pg8::StaticOrder S; S.init(NTOK, 2048, G, (int)blockIdx.x); EpiB<0> E{WP(bf16, WS_KVM), 2048, WP(float, WS_RSKV)};
          pg8::gemm_phase<EpiB<0>, pg8::StaticOrder, true, true>(lds, g, S, E); }
        }
        GRIDBAR();
        PH_ON(4) {
            LAS unsigned* uq = (LAS unsigned*)(lds + MISC_OFF + 64);
            { PHL; gu32* ctl = WP(gu32, WS_CTL); bf16* H = WP(bf16, WS_H); bf16* MIX = WP(bf16, WS_MIX);
            for (;;) {
                __syncthreads(); if (tid == 0) *uq = __hip_atomic_fetch_add(ctl + CW_Q + 64 * (L * 4 + 0), 1u, RLX_AGENT); __syncthreads();
                const int u = (int)*uq; if (u >= 512) break;
                const int qb = 31 - u / 16, bh = u % 16, b = bh / 8, hd = bh % 8;
                AttnDesc d; d.Q = H + C_AQ + hd * 128; d.K = H + C_AK + hd * 128; d.K2 = nullptr; d.V = H + C_AV + hd * 128; d.O = MIX + hd * 128; d.LSE = nullptr; d.cosT = nullptr; d.sinT = nullptr;
                d.ldq = NINP; d.ldk = NINP; d.ldk2 = 0; d.ldv = NINP; d.ldo = DM; d.lse_ld = 0; d.row0 = b * SEQ; d.rstride = 1; d.iq0 = qb * 256; d.W = 1 << 29; d.pos0 = 0; d.scale = 0.08838834764831845f;
                attn_unit<128, 1, false>(lds, d, tid, wave, lane);
            } }
            { PHL; gu32* ctl = WP(gu32, WS_CTL); bf16* QM = WP(bf16, WS_QM); bf16* KVM = WP(bf16, WS_KVM);
            for (;;) {
                __syncthreads(); if (tid == 0) *uq = __hip_atomic_fetch_add(ctl + CW_Q + 64 * (L * 4 + 1), 1u, RLX_AGENT); __syncthreads();
                const int u = (int)*uq; if (u >= 512) break;
                const int qb = 31 - u / 16, bh = u % 16, b = bh / 8, hd = bh % 8;
                AttnDesc d; d.Q = QM + hd * 192; d.K = KVM + hd * 256; d.K2 = WP(bf16, WS_H) + C_CKR; d.V = KVM + hd * 256 + 128; d.O = WP(bf16, WS_MIX) + 2048 + hd * 128; d.LSE = nullptr; d.cosT = WP(float, WS_COS64); d.sinT = WP(float, WS_SIN64);
                d.ldq = 1536; d.ldk = 2048; d.ldk2 = NINP; d.ldv = 2048; d.ldo = DM; d.lse_ld = 0; d.row0 = b * SEQ; d.rstride = 1; d.iq0 = qb * 256; d.W = 1 << 29; d.pos0 = 0; d.scale = 0.07216878364870323f;
                attn_unit<192, 0, true>(lds, d, tid, wave, lane);
            } }
            { PHL; gu32* ctl = WP(gu32, WS_CTL); bf16* H = WP(bf16, WS_H);
            for (;;) {
                __syncthreads(); if (tid == 0) *uq = __hip_atomic_fetch_add(ctl + CW_Q + 64 * (L * 4 + 2), 1u, RLX_AGENT); __syncthreads();
                const int u = (int)*uq; if (u >= 2560) break;
                AttnDesc d; d.K2 = nullptr; d.cosT = nullptr; d.sinT = nullptr; d.ldq = NINP; d.ldk = NINP; d.ldk2 = 0; d.ldv = NINP; d.ldo = 1024; d.pos0 = 0; d.scale = 0.08838834764831845f;
                if (u < 1024) {
                    const int qb = 31 - u / 32, v = u % 32, b = v / 16, vh = v % 16, hd = vh / 4, map = (vh / 2) % 2, half = vh % 2;
                    d.Q = H + C_DQ + hd * 256 + map * 128; d.K = H + C_DK + hd * 256 + map * 128; d.V = H + C_DV + hd * 256 + half * 128; d.O = WP(bf16, WS_DO) + (size_t)map * NTOK * 1024 + hd * 256 + half * 128; d.LSE = nullptr; d.lse_ld = 0;
                    d.row0 = b * SEQ; d.rstride = 1; d.iq0 = qb * 256; d.W = 1 << 29;
                } else {
                    const int w = u - 1024, b = w / 768, r = w % 768, hd = r / 96, r2 = r % 96, br = r2 / 32, idx = r2 % 32;
                    const int dil = br == 0 ? 1 : (br == 1 ? 4 : 16), nqb = 32 / dil, res = idx / nqb, qb = idx % nqb;
                    d.Q = H + C_BQ + hd * 128; d.K = H + C_BK + hd * 128; d.V = H + C_BV + hd * 128; d.O = WP(bf16, WS_DP) + (size_t)br * NTOK * 1024 + hd * 128; d.LSE = WP(float, WS_LSE) + (size_t)br * NTOK * 8 + hd; d.lse_ld = 8;
                    d.row0 = b * SEQ + res; d.rstride = dil; d.iq0 = qb * 256; d.W = 128;
                }
                attn_unit<128, 0, false>(lds, d, tid, wave, lane);
            } }
        }
        GRIDBAR();
        PH_ON(5) { PHL; const float lam_init = (L == 0) ? 0.2f : 0.35550906f;
          combine_rows(WP(bf16, WS_DP), WP(float, WS_LSE), WP(bf16, WS_DO), args.in[8] + (size_t)L * 512, args.in[9] + (size_t)L * 256, lam_init, WP(bf16, WS_MIX), gw, ngw, lane); }
        GRIDBAR();
        PH_ON(6) { PHL; pg8::Gemm g{WP(bf16, WS_MIX), WP(bf16, WS_WO), NTOK, DM, DM, DM}; pg8::StaticOrder S; S.init(NTOK, DM, G, (int)blockIdx.x); EpiB<0> E{WP(bf16, WS_Y), DM, nullptr};
          pg8::gemm_phase<EpiB<0>, pg8::StaticOrder, true, true>(lds, g, S, E); }
        GRIDBAR();
        PH_ON(7) { PHL; ln_rows(L == 0 ? args.in[0] : args.out, WP(bf16, WS_Y), args.in[10] + (size_t)L * DM, args.in[11] + (size_t)L * DM, args.out, WP(bf16, WS_XB), gw, ngw, lane); }
        GRIDBAR();
        PH_ON(8) { PHL; pg8::Gemm g{WP(bf16, WS_XB), WP(bf16, WS_FF1), NTOK, DFF, DM, DM}; pg8::StaticOrder S; S.init(NTOK, DFF, G, (int)blockIdx.x); EpiB<2> E{WP(bf16, WS_H), DFF, nullptr};
          pg8::gemm_phase<EpiB<2>, pg8::StaticOrder, true, true>(lds, g, S, E); }
        GRIDBAR();
        PH_ON(9) { PHL; pg8::Gemm g{WP(bf16, WS_H), WP(bf16, WS_FF2), NTOK, DM, DFF, DFF}; pg8::StaticOrder S; S.init(NTOK, DM, G, (int)blockIdx.x); EpiB<0> E{WP(bf16, WS_Y), DM, nullptr};
          pg8::gemm_phase<EpiB<0>, pg8::StaticOrder, true, true>(lds, g, S, E); }
        GRIDBAR();
        PH_ON(10) {
        { PHL; ln_rows(args.out, WP(bf16, WS_Y), args.in[14] + (size_t)L * DM, args.in[15] + (size_t)L * DM, args.out, WP(bf16, WS_XB), gw, ngw, lane); }
        __syncthreads();
        { PHL; pg8::Gemm g{WP(bf16, WS_PB), WP(bf16, WS_PROJ), NTOK, DM, PLE, PLE}; pg8::StaticOrder S; S.init(NTOK, DM, G, (int)blockIdx.x); EpiB<0> E{WP(bf16, WS_H), DM, nullptr};
          pg8::gemm_phase<EpiB<0>, pg8::StaticOrder, true, true>(lds, g, S, E); }
        }
        GRIDBAR();
        PH_ON(11) { PHL; pg8::Gemm g{WP(bf16, WS_XB), WP(bf16, WS_GATE), NTOK, DM, DM, DM}; pg8::StaticOrder S; S.init(NTOK, DM, G, (int)blockIdx.x); EpiG E{WP(bf16, WS_Y), WP(bf16, WS_H), DM};
          pg8::gemm_phase<EpiG, pg8::StaticOrder, true, true>(lds, g, S, E); }
        GRIDBAR();
        PH_ON(12) { PHL; ln_rows(args.out, WP(bf16, WS_Y), args.in[18] + (size_t)L * DM, args.in[19] + (size_t)L * DM, args.out, WP(bf16, WS_XB), gw, ngw, lane); }

        xcd_barrier(bar);
    }
    { constexpr int L = 1; constexpr int PH = -1;

        PH_ON(0) {
            PHL; const size_t gtid = (size_t)blockIdx.x * 512 + tid, gthreads = (size_t)G * 512;
            LAS float* scr = (LAS float*)(lds + wave * 16384);
            constexpr int I_IN = 64 * (NIN / 32), I_O = 64 * 128, I_UQ = 16 * 48, I_UKV = 8 * 64, I_F1 = 64 * 512, I_F2 = 256 * 128, I_G = 64 * 128, I_P = 4 * 128;
            constexpr int NITEMS = I_IN + I_O + I_UQ + I_UKV + I_F1 + I_F2 + I_G + I_P;
            for (int it = gw; it < NITEMS; it += ngw) {
                int r = it;
                if (r < I_IN) { transpose_item(args.in[2] + (size_t)L * DM * NIN, DM, NIN, WP(bf16, WS_WIN), nullptr, scr, r, lane); continue; } r -= I_IN;
                if (r < I_O) { transpose_item(args.in[3] + (size_t)L * DM * DM, DM, DM, WP(bf16, WS_WO), nullptr, scr, r, lane); continue; } r -= I_O;
                if (r < I_UQ) { transpose_item(args.in[5] + (size_t)L * 1024 * 1536, 1024, 1536, WP(bf16, WS_UQ), args.in[4] + (size_t)L * 1024, scr, r, lane); continue; } r -= I_UQ;
                if (r < I_UKV) { transpose_item(args.in[7] + (size_t)L * 512 * 2048, 512, 2048, WP(bf16, WS_UKV), args.in[6] + (size_t)L * 512, scr, r, lane); continue; } r -= I_UKV;
                if (r < I_F1) { transpose_item(args.in[12] + (size_t)L * DM * DFF, DM, DFF, WP(bf16, WS_FF1), nullptr, scr, r, lane); continue; } r -= I_F1;
                if (r < I_F2) { transpose_item(args.in[13] + (size_t)L * DFF * DM, DFF, DM, WP(bf16, WS_FF2), nullptr, scr, r, lane); continue; } r -= I_F2;
                if (r < I_G) { transpose_item(args.in[16] + (size_t)L * DM * DM, DM, DM, WP(bf16, WS_GATE), nullptr, scr, r, lane); continue; } r -= I_G;
                transpose_item(args.in[17] + (size_t)L * PLE * DM, PLE, DM, WP(bf16, WS_PROJ), nullptr, scr, r, lane);
            }
            { v4u z = {0u, 0u, 0u, 0u}; v4u* pad = (v4u*)(WP(bf16, WS_WIN) + (size_t)NIN * DM); const size_t n16 = (size_t)(NINP - NIN) * DM / 8; for (size_t i = gtid; i < n16; i += gthreads) pad[i] = z; }
            cvt_rows(args.in[1] + (size_t)L * NTOK * PLE, WP(bf16, WS_PB), (size_t)NTOK * PLE / 8, gtid, gthreads);
            if (L == 0) {
                cvt_rows(args.in[0], WP(bf16, WS_XB), (size_t)NTOK * DM / 8, gtid, gthreads);
                float* cos128 = WP(float, WS_COS128); float* sin128 = WP(float, WS_SIN128); float* cos64 = WP(float, WS_COS64); float* sin64 = WP(float, WS_SIN64);
                for (size_t i = gtid; i < (size_t)SEQ * 64; i += gthreads) { const int pos = (int)(i >> 6), j = (int)(i & 63); const float inv = powf(10000.0f, -(float)j / 64.0f); const float ang = (float)pos * inv; cos128[i] = cosf(ang); sin128[i] = sinf(ang); }
                for (size_t i = gtid; i < (size_t)SEQ * 32; i += gthreads) { const int pos = (int)(i >> 5), j = (int)(i & 31); const float inv = powf(10000.0f, -(float)j / 32.0f); const float ang = (float)pos * inv; cos64[i] = cosf(ang); sin64[i] = sinf(ang); }
            }
        }
        GRIDBAR();
        PH_ON(1) { PHL; pg8::Gemm g{WP(bf16, WS_XB), WP(bf16, WS_WIN), NTOK, NINP, DM, DM}; pg8::StaticOrder S; S.init(NTOK, NINP, G, (int)blockIdx.x); EpiB<0> E{WP(bf16, WS_H), NINP, nullptr};
          pg8::gemm_phase<EpiB<0>, pg8::StaticOrder, true, true>(lds, g, S, E); }
        GRIDBAR();
        PH_ON(2) { PHL; rope_rows(WP(bf16, WS_H), WP(float, WS_COS128), WP(float, WS_SIN128), WP(float, WS_COS64), WP(float, WS_SIN64), WP(float, WS_RSQ), WP(float, WS_RSKV), gw, ngw, lane); }
        GRIDBAR();
        PH_ON(3) {
        { PHL; pg8::Gemm g{WP(bf16, WS_H) + C_CQ, WP(bf16, WS_UQ), NTOK, 1536, 1024, NINP}; pg8::StaticOrder S; S.init(NTOK, 1536, G, (int)blockIdx.x); EpiB<0> E{WP(bf16, WS_QM), 1536, WP(float, WS_RSQ)};
          pg8::gemm_phase<EpiB<0>, pg8::StaticOrder, true, true>(lds, g, S, E); }
        __syncthreads();
        { PHL; pg8::Gemm g{WP(bf16, WS_H) + C_CKV, WP(bf16, WS_UKV), NTOK, 2048, 512, NINP}; pg8::StaticOrder S; S.init(NTOK, 2048, G, (int)blockIdx.x); EpiB<0> E{WP(bf16, WS_KVM), 2048, WP(float, WS_RSKV)};
          pg8::gemm_phase<EpiB<0>, pg8::StaticOrder, true, true>(lds, g, S, E); }
        }
        GRIDBAR();
        PH_ON(4) {
            LAS unsigned* uq = (LAS unsigned*)(lds + MISC_OFF + 64);
            { PHL; gu32* ctl = WP(gu32, WS_CTL); bf16* H = WP(bf16, WS_H); bf16* MIX = WP(bf16, WS_MIX);
            for (;;) {
                __syncthreads(); if (tid == 0) *uq = __hip_atomic_fetch_add(ctl + CW_Q + 64 * (L * 4 + 0), 1u, RLX_AGENT); __syncthreads();
                const int u = (int)*uq; if (u >= 512) break;
                const int qb = 31 - u / 16, bh = u % 16, b = bh / 8, hd = bh % 8;
                AttnDesc d; d.Q = H + C_AQ + hd * 128; d.K = H + C_AK + hd * 128; d.K2 = nullptr; d.V = H + C_AV + hd * 128; d.O = MIX + hd * 128; d.LSE = nullptr; d.cosT = nullptr; d.sinT = nullptr;
                d.ldq = NINP; d.ldk = NINP; d.ldk2 = 0; d.ldv = NINP; d.ldo = DM; d.lse_ld = 0; d.row0 = b * SEQ; d.rstride = 1; d.iq0 = qb * 256; d.W = 1 << 29; d.pos0 = 0; d.scale = 0.08838834764831845f;
                attn_unit<128, 1, false>(lds, d, tid, wave, lane);
            } }
            { PHL; gu32* ctl = WP(gu32, WS_CTL); bf16* QM = WP(bf16, WS_QM); bf16* KVM = WP(bf16, WS_KVM);
            for (;;) {
                __syncthreads(); if (tid == 0) *uq = __hip_atomic_fetch_add(ctl + CW_Q + 64 * (L * 4 + 1), 1u, RLX_AGENT); __syncthreads();
                const int u = (int)*uq; if (u >= 512) break;
                const int qb = 31 - u / 16, bh = u % 16, b = bh / 8, hd = bh % 8;
                AttnDesc d; d.Q = QM + hd * 192; d.K = KVM + hd * 256; d.K2 = WP(bf16, WS_H) + C_CKR; d.V = KVM + hd * 256 + 128; d.O = WP(bf16, WS_MIX) + 2048 + hd * 128; d.LSE = nullptr; d.cosT = WP(float, WS_COS64); d.sinT = WP(float, WS_SIN64);
                d.ldq = 1536; d.ldk = 2048; d.ldk2 = NINP; d.ldv = 2048; d.ldo = DM; d.lse_ld = 0; d.row0 = b * SEQ; d.rstride = 1; d.iq0 = qb * 256; d.W = 1 << 29; d.pos0 = 0; d.scale = 0.07216878364870323f;
                attn_unit<192, 0, true>(lds, d, tid, wave, lane);
            } }
            { PHL; gu32* ctl = WP(gu32, WS_CTL); bf16* H = WP(bf16, WS_H);
            for (;;) {
                __syncthreads(); if (tid == 0) *uq = __hip_atomic_fetch_add(ctl + CW_Q + 64 * (L * 4 + 2), 1u, RLX_AGENT); __syncthreads();
                const int u = (int)*uq; if (u >= 2560) break;
                AttnDesc d; d.K2 = nullptr; d.cosT = nullptr; d.sinT = nullptr; d.ldq = NINP; d.ldk = NINP; d.ldk2 = 0; d.ldv = NINP; d.ldo = 1024; d.pos0 = 0; d.scale = 0.08838834764831845f;
                if (u < 1024) {
                    const int qb = 31 - u / 32, v = u % 32, b = v / 16, vh = v % 16, hd = vh / 4, map = (vh / 2) % 2, half = vh % 2;
                    d.Q = H + C_DQ + hd * 256 + map * 128; d.K = H + C_DK + hd * 256 + map * 128; d.V = H + C_DV + hd * 256 + half * 128; d.O = WP(bf16, WS_DO) + (size_t)map * NTOK * 1024 + hd * 256 + half * 128; d.LSE = nullptr; d.lse_ld = 0;
                    d.row0 = b * SEQ; d.rstride = 1; d.iq0 = qb * 256; d.W = 1 << 29;
                } else {
                    const int w = u - 1024, b = w / 768, r = w % 768, hd = r / 96, r2 = r % 96, br = r2 / 32, idx = r2 % 32;
                    const int dil = br == 0 ? 1 : (br == 1 ? 4 : 16), nqb = 32 / dil, res = idx / nqb, qb = idx % nqb;
                    d.Q = H + C_BQ + hd * 128; d.K = H + C_BK + hd * 128; d.V = H + C_BV + hd * 128; d.O = WP(bf16, WS_DP) + (size_t)br * NTOK * 1024 + hd * 128; d.LSE = WP(float, WS_LSE) + (size_t)br * NTOK * 8 + hd; d.lse_ld = 8;
                    d.row0 = b * SEQ + res; d.rstride = dil; d.iq0 = qb * 256; d.W = 128;
                }
                attn_unit<128, 0, false>(lds, d, tid, wave, lane);
            } }
        }
        GRIDBAR();
        PH_ON(5) { PHL; const float lam_init = (L == 0) ? 0.2f : 0.35550906f;
          combine_rows(WP(bf16, WS_DP), WP(float, WS_LSE), WP(bf16, WS_DO), args.in[8] + (size_t)L * 512, args.in[9] + (size_t)L * 256, lam_init, WP(bf16, WS_MIX), gw, ngw, lane); }
        GRIDBAR();
        PH_ON(6) { PHL; pg8::Gemm g{WP(bf16, WS_MIX), WP(bf16, WS_WO), NTOK, DM, DM, DM}; pg8::StaticOrder S; S.init(NTOK, DM, G, (int)blockIdx.x); EpiB<0> E{WP(bf16, WS_Y), DM, nullptr};
          pg8::gemm_phase<EpiB<0>, pg8::StaticOrder, true, true>(lds, g, S, E); }
        GRIDBAR();
        PH_ON(7) { PHL; ln_rows(L == 0 ? args.in[0] : args.out, WP(bf16, WS_Y), args.in[10] + (size_t)L * DM, args.in[11] + (size_t)L * DM, args.out, WP(bf16, WS_XB), gw, ngw, lane); }
        GRIDBAR();
        PH_ON(8) { PHL; pg8::Gemm g{WP(bf16, WS_XB), WP(bf16, WS_FF1), NTOK, DFF, DM, DM}; pg8::StaticOrder S; S.init(NTOK, DFF, G, (int)blockIdx.x); EpiB<2> E{WP(bf16, WS_H), DFF, nullptr};
          pg8::gemm_phase<EpiB<2>, pg8::StaticOrder, true, true>(lds, g, S, E); }
        GRIDBAR();
        PH_ON(9) { PHL; pg8::Gemm g{WP(bf16, WS_H), WP(bf16, WS_FF2), NTOK, DM, DFF, DFF}; pg8::StaticOrder S; S.init(NTOK, DM, G, (int)blockIdx.x); EpiB<0> E{WP(bf16, WS_Y), DM, nullptr};
          pg8::gemm_phase<EpiB<0>, pg8::StaticOrder, true, true>(lds, g, S, E); }
        GRIDBAR();
        PH_ON(10) {
        { PHL; ln_rows(args.out, WP(bf16, WS_Y), args.in[14] + (size_t)L * DM, args.in[15] + (size_t)L * DM, args.out, WP(bf16, WS_XB), gw, ngw, lane); }
        __syncthreads();
        { PHL; pg8::Gemm g{WP(bf16, WS_PB), WP(bf16, WS_PROJ), NTOK, DM, PLE, PLE}; pg8::StaticOrder S; S.init(NTOK, DM, G, (int)blockIdx.x); EpiB<0> E{WP(bf16, WS_H), DM, nullptr};
          pg8::gemm_phase<EpiB<0>, pg8::StaticOrder, true, true>(lds, g, S, E); }
        }
        GRIDBAR();
        PH_ON(11) { PHL; pg8::Gemm g{WP(bf16, WS_XB), WP(bf16, WS_GATE), NTOK, DM, DM, DM}; pg8::StaticOrder S; S.init(NTOK, DM, G, (int)blockIdx.x); EpiG E{WP(bf16, WS_Y), WP(bf16, WS_H), DM};
          pg8::gemm_phase<EpiG, pg8::StaticOrder, true, true>(lds, g, S, E); }
        GRIDBAR();
        PH_ON(12) { PHL; ln_rows(args.out, WP(bf16, WS_Y), args.in[18] + (size_t)L * DM, args.in[19] + (size_t)L * DM, args.out, WP(bf16, WS_XB), gw, ngw, lane); }

    }
}
#else
template <int PH> __global__ void __launch_bounds__(512, 2) hybrid_ph(Args args) {

    extern __shared__ __attribute__((aligned(16))) unsigned char lds_raw[];
    LAS unsigned char* lds = (LAS unsigned char*)lds_raw;
    volatile LAS unsigned* MISC = (volatile LAS unsigned*)(lds + MISC_OFF);
    for (int u = threadIdx.x; u < (LDS_BYTES - RING_BYTES) / 4; u += 512) ((LAS unsigned*)(lds + RING_BYTES))[u] = 0u;
    __syncthreads();

    XcdBarrier bar; bar.bar = nullptr; bar.x = 0; bar.st = nullptr; (void)bar; (void)MISC;
    const int L = args.L;

        PH_ON(0) {
            PHL; const size_t gtid = (size_t)blockIdx.x * 512 + tid, gthreads = (size_t)G * 512;
            LAS float* scr = (LAS float*)(lds + wave * 16384);
            constexpr int I_IN = 64 * (NIN / 32), I_O = 64 * 128, I_UQ = 16 * 48, I_UKV = 8 * 64, I_F1 = 64 * 512, I_F2 = 256 * 128, I_G = 64 * 128, I_P = 4 * 128;
            constexpr int NITEMS = I_IN + I_O + I_UQ + I_UKV + I_F1 + I_F2 + I_G + I_P;
            for (int it = gw; it < NITEMS; it += ngw) {
                int r = it;
                if (r < I_IN) { transpose_item(args.in[2] + (size_t)L * DM * NIN, DM, NIN, WP(bf16, WS_WIN), nullptr, scr, r, lane); continue; } r -= I_IN;
                if (r < I_O) { transpose_item(args.in[3] + (size_t)L * DM * DM, DM, DM, WP(bf16, WS_WO), nullptr, scr, r, lane); continue; } r -= I_O;
                if (r < I_UQ) { transpose_item(args.in[5] + (size_t)L * 1024 * 1536, 1024, 1536, WP(bf16, WS_UQ), args.in[4] + (size_t)L * 1024, scr, r, lane); continue; } r -= I_UQ;
                if (r < I_UKV) { transpose_item(args.in[7] + (size_t)L * 512 * 2048, 512, 2048, WP(bf16, WS_UKV), args.in[6] + (size_t)L * 512, scr, r, lane); continue; } r -= I_UKV;
                if (r < I_F1) { transpose_item(args.in[12] + (size_t)L * DM * DFF, DM, DFF, WP(bf16, WS_FF1), nullptr, scr, r, lane); continue; } r -= I_F1;
                if (r < I_F2) { transpose_item(args.in[13] + (size_t)L * DFF * DM, DFF, DM, WP(bf16, WS_FF2), nullptr, scr, r, lane); continue; } r -= I_F2;
                if (r < I_G) { transpose_item(args.in[16] + (size_t)L * DM * DM, DM, DM, WP(bf16, WS_GATE), nullptr, scr, r, lane); continue; } r -= I_G;
                transpose_item(args.in[17] + (size_t)L * PLE * DM, PLE, DM, WP(bf16, WS_PROJ), nullptr, scr, r, lane);
            }
            { v4u z = {0u, 0u, 0u, 0u}; v4u* pad = (v4u*)(WP(bf16, WS_WIN) + (size_t)NIN * DM); const size_t n16 = (size_t)(NINP - NIN) * DM / 8; for (size_t i = gtid; i < n16; i += gthreads) pad[i] = z; }
            cvt_rows(args.in[1] + (size_t)L * NTOK * PLE, WP(bf16, WS_PB), (size_t)NTOK * PLE / 8, gtid, gthreads);
            if (L == 0) {
                cvt_rows(args.in[0], WP(bf16, WS_XB), (size_t)NTOK * DM / 8, gtid, gthreads);
                float* cos128 = WP(float, WS_COS128); float* sin128 = WP(float, WS_SIN128); float* cos64 = WP(float, WS_COS64); float* sin64 = WP(float, WS_SIN64);
                for (size_t i = gtid; i < (size_t)SEQ * 64; i += gthreads) { const int pos = (int)(i >> 6), j = (int)(i & 63); const float inv = powf(10000.0f, -(float)j / 64.0f); const float ang = (float)pos * inv; cos128[i] = cosf(ang); sin128[i] = sinf(ang); }
                for (size_t i = gtid; i < (size_t)SEQ * 32; i += gthreads) { const int pos = (int)(i >> 5), j = (int)(i & 31); const float inv = powf(10000.0f, -(float)j / 32.0f); const float ang = (float)pos * inv; cos64[i] = cosf(ang); sin64[i] = sinf(ang); }
            }
        }
        GRIDBAR();
        PH_ON(1) { PHL; pg8::Gemm g{WP(bf16, WS_XB), WP(bf16, WS_WIN), NTOK, NINP, DM, DM}; pg8::StaticOrder S; S.init(NTOK, NINP, G, (int)blockIdx.x); EpiB<0> E{WP(bf16, WS_H), NINP, nullptr};
          pg8::gemm_phase<EpiB<0>, pg8::StaticOrder, true, true>(lds, g, S, E); }
        GRIDBAR();
        PH_ON(2) { PHL; rope_rows(WP(bf16, WS_H), WP(float, WS_COS128), WP(float, WS_SIN128), WP(float, WS_COS64), WP(float, WS_SIN64), WP(float, WS_RSQ), WP(float, WS_RSKV), gw, ngw, lane); }
        GRIDBAR();
        PH_ON(3) {
        { PHL; pg8::Gemm g{WP(bf16, WS_H) + C_CQ, WP(bf16, WS_UQ), NTOK, 1536, 1024, NINP}; pg8::StaticOrder S; S.init(NTOK, 1536, G, (int)blockIdx.x); EpiB<0> E{WP(bf16, WS_QM), 1536, WP(float, WS_RSQ)};
          pg8::gemm_phase<EpiB<0>, pg8::StaticOrder, true, true>(lds, g, S, E); }
        __syncthreads();
        { PHL; pg8::Gemm g{WP(bf16, WS_H) + C_CKV, WP(bf16, WS_UKV), NTOK, 2048, 512, NINP}; pg8::StaticOrder S; S.init(NTOK, 2048, G, (int)blockIdx.x); EpiB<0> E{WP(bf16, WS_KVM), 2048, WP(float, WS_RSKV)};
          pg8::gemm_phase<EpiB<0>, pg8::StaticOrder, true, true>(lds, g, S, E); }
        }
        GRIDBAR();
        PH_ON(4) {
            LAS unsigned* uq = (LAS unsigned*)(lds + MISC_OFF + 64);
            { PHL; gu32* ctl = WP(gu32, WS_CTL); bf16* H = WP(bf16, WS_H); bf16* MIX = WP(bf16, WS_MIX);
            for (;;) {
                __syncthreads(); if (tid == 0) *uq = __hip_atomic_fetch_add(ctl + CW_Q + 64 * (L * 4 + 0), 1u, RLX_AGENT); __syncthreads();
                const int u = (int)*uq; if (u >= 512) break;
                const int qb = 31 - u / 16, bh = u % 16, b = bh / 8, hd = bh % 8;
                AttnDesc d; d.Q = H + C_AQ + hd * 128; d.K = H + C_AK + hd * 128; d.K2 = nullptr; d.V = H + C_AV + hd * 128; d.O = MIX + hd * 128; d.LSE = nullptr; d.cosT = nullptr; d.sinT = nullptr;
                d.ldq = NINP; d.ldk = NINP; d.ldk2 = 0; d.ldv = NINP; d.ldo = DM; d.lse_ld = 0; d.row0 = b * SEQ; d.rstride = 1; d.iq0 = qb * 256; d.W = 1 << 29; d.pos0 = 0; d.scale = 0.08838834764831845f;
                attn_unit<128, 1, false>(lds, d, tid, wave, lane);
            } }
            { PHL; gu32* ctl = WP(gu32, WS_CTL); bf16* QM = WP(bf16, WS_QM); bf16* KVM = WP(bf16, WS_KVM);
            for (;;) {
                __syncthreads(); if (tid == 0) *uq = __hip_atomic_fetch_add(ctl + CW_Q + 64 * (L * 4 + 1), 1u, RLX_AGENT); __syncthreads();
                const int u = (int)*uq; if (u >= 512) break;
                const int qb = 31 - u / 16, bh = u % 16, b = bh / 8, hd = bh % 8;
                AttnDesc d; d.Q = QM + hd * 192; d.K = KVM + hd * 256; d.K2 = WP(bf16, WS_H) + C_CKR; d.V = KVM + hd * 256 + 128; d.O = WP(bf16, WS_MIX) + 2048 + hd * 128; d.LSE = nullptr; d.cosT = WP(float, WS_COS64); d.sinT = WP(float, WS_SIN64);
                d.ldq = 1536; d.ldk = 2048; d.ldk2 = NINP; d.ldv = 2048; d.ldo = DM; d.lse_ld = 0; d.row0 = b * SEQ; d.rstride = 1; d.iq0 = qb * 256; d.W = 1 << 29; d.pos0 = 0; d.scale = 0.07216878364870323f;
                attn_unit<192, 0, true>(lds, d, tid, wave, lane);
            } }
            { PHL; gu32* ctl = WP(gu32, WS_CTL); bf16* H = WP(bf16, WS_H);
            for (;;) {
                __syncthreads(); if (tid == 0) *uq = __hip_atomic_fetch_add(ctl + CW_Q + 64 * (L * 4 + 2), 1u, RLX_AGENT); __syncthreads();
                const int u = (int)*uq; if (u >= 2560) break;
                AttnDesc d; d.K2 = nullptr; d.cosT = nullptr; d.sinT = nullptr; d.ldq = NINP; d.ldk = NINP; d.ldk2 = 0; d.ldv = NINP; d.ldo = 1024; d.pos0 = 0; d.scale = 0.08838834764831845f;
                if (u < 1024) {
                    const int qb = 31 - u / 32, v = u % 32, b = v / 16, vh = v % 16, hd = vh / 4, map = (vh / 2) % 2, half = vh % 2;
                    d.Q = H + C_DQ + hd * 256 + map * 128; d.K = H + C_DK + hd * 256 + map * 128; d.V = H + C_DV + hd * 256 + half * 128; d.O = WP(bf16, WS_DO) + (size_t)map * NTOK * 1024 + hd * 256 + half * 128; d.LSE = nullptr; d.lse_ld = 0;
                    d.row0 = b * SEQ; d.rstride = 1; d.iq0 = qb * 256; d.W = 1 << 29;
                } else {
                    const int w = u - 1024, b = w / 768, r = w % 768, hd = r / 96, r2 = r % 96, br = r2 / 32, idx = r2 % 32;
                    const int dil = br == 0 ? 1 : (br == 1 ? 4 : 16), nqb = 32 / dil, res = idx / nqb, qb = idx % nqb;
                    d.Q = H + C_BQ + hd * 128; d.K = H + C_BK + hd * 128; d.V = H + C_BV + hd * 128; d.O = WP(bf16, WS_DP) + (size_t)br * NTOK * 1024 + hd * 128; d.LSE = WP(float, WS_LSE) + (size_t)br * NTOK * 8 + hd; d.lse_ld = 8;
                    d.row0 = b * SEQ + res; d.rstride = dil; d.iq0 = qb * 256; d.W = 128;
                }
                attn_unit<128, 0, false>(lds, d, tid, wave, lane);
            } }
        }
        GRIDBAR();
        PH_ON(5) { PHL; const float lam_init = (L == 0) ? 0.2f : 0.35550906f;
          combine_rows(WP(bf16, WS_DP), WP(float, WS_LSE), WP(bf16, WS_DO), args.in[8] + (size_t)L * 512, args.in[9] + (size_t)L * 256, lam_init, WP(bf16, WS_MIX), gw, ngw, lane); }
        GRIDBAR();
        PH_ON(6) { PHL; pg8::Gemm g{WP(bf16, WS_MIX), WP(bf16, WS_WO), NTOK, DM, DM, DM}; pg8::StaticOrder S; S.init(NTOK, DM, G, (int)blockIdx.x); EpiB<0> E{WP(bf16, WS_Y), DM, nullptr};
          pg8::gemm_phase<EpiB<0>, pg8::StaticOrder, true, true>(lds, g, S, E); }
        GRIDBAR();
        PH_ON(7) { PHL; ln_rows(L == 0 ? args.in[0] : args.out, WP(bf16, WS_Y), args.in[10] + (size_t)L * DM, args.in[11] + (size_t)L * DM, args.out, WP(bf16, WS_XB), gw, ngw, lane); }
        GRIDBAR();
        PH_ON(8) { PHL; pg8::Gemm g{WP(bf16, WS_XB), WP(bf16, WS_FF1), NTOK, DFF, DM, DM}; pg8::StaticOrder S; S.init(NTOK, DFF, G, (int)blockIdx.x); EpiB<2> E{WP(bf16, WS_H), DFF, nullptr};
          pg8::gemm_phase<EpiB<2>, pg8::StaticOrder, true, true>(lds, g, S, E); }
        GRIDBAR();
        PH_ON(9) { PHL; pg8::Gemm g{WP(bf16, WS_H), WP(bf16, WS_FF2), NTOK, DM, DFF, DFF}; pg8::StaticOrder S; S.init(NTOK, DM, G, (int)blockIdx.x); EpiB<0> E{WP(bf16, WS_Y), DM, nullptr};
          pg8::gemm_phase<EpiB<0>, pg8::StaticOrder, true, true>(lds, g, S, E); }
        GRIDBAR();
        PH_ON(10) {
        { PHL; ln_rows(args.out, WP(bf16, WS_Y), args.in[14] + (size_t)L * DM, args.in[15] + (size_t)L * DM, args.out, WP(bf16, WS_XB), gw, ngw, lane); }
        __syncthreads();
        { PHL; pg8::Gemm g{WP(bf16, WS_PB), WP(bf16, WS_PROJ), NTOK, DM, PLE, PLE}; pg8::StaticOrder S; S.init(NTOK, DM, G, (int)blockIdx.x); EpiB<0> E{WP(bf16, WS_H), DM, nullptr};
          pg8::gemm_phase<EpiB<0>, pg8::StaticOrder, true, true>(lds, g, S, E); }
        }
        GRIDBAR();
        PH_ON(11) { PHL; pg8::Gemm g{WP(bf16, WS_XB), WP(bf16, WS_GATE), NTOK, DM, DM, DM}; pg8::StaticOrder S; S.init(NTOK, DM, G, (int)blockIdx.x); EpiG E{WP(bf16, WS_Y), WP(bf16, WS_H), DM};
          pg8::gemm_phase<EpiG, pg8::StaticOrder, true, true>(lds, g, S, E); }
        GRIDBAR();
        PH_ON(12) { PHL; ln_rows(args.out, WP(bf16, WS_Y), args.in[18] + (size_t)L * DM, args.in[19] + (size_t)L * DM, args.out, WP(bf16, WS_XB), gw, ngw, lane); }

}
template <int PH> static void launch_ph(int grid, hipStream_t stream, Args a) {
    static bool attr = false;
    if (!attr) { (void)hipFuncSetAttribute((const void*)hybrid_ph<PH>, hipFuncAttributeMaxDynamicSharedMemorySize, LDS_BYTES); attr = true; }
    hipLaunchKernelGGL(hybrid_ph<PH>, dim3(grid), dim3(512), LDS_BYTES, stream, a);
}
#endif

extern "C" void kernel_launch(void* const* d_in, const int* in_sizes, int n_in, void* d_out, int out_size, void* d_ws, size_t ws_size, hipStream_t stream) {
    static int grid = 0;
    if (grid == 0) {
        if (n_in != 20 || out_size != NTOK * DM || ws_size < WS_END) { fprintf(stderr, "kernel_launch: unexpected shapes (n_in %d out %d ws %zu)\n", n_in, out_size, ws_size); grid = -1; return; }
        int dev = 0, cus = 0;
        if (hipGetDevice(&dev) != hipSuccess || hipDeviceGetAttribute(&cus, hipDeviceAttributeMultiprocessorCount, dev) != hipSuccess) { grid = -1; return; }
#if ONE_LAUNCH
        int per_cu = 0;
        if (hipFuncSetAttribute((const void*)hybrid_one, hipFuncAttributeMaxDynamicSharedMemorySize, LDS_BYTES) != hipSuccess) { fprintf(stderr, "kernel_launch: hipFuncSetAttribute failed\n"); grid = -1; return; }
        if (hipOccupancyMaxActiveBlocksPerMultiprocessor(&per_cu, (const void*)hybrid_one, 512, LDS_BYTES) != hipSuccess || per_cu < 1) { fprintf(stderr, "kernel_launch: occupancy query says %d blocks per CU\n", per_cu); }
        (void)hipGetLastError();
#endif
        grid = cus;
    }
    if (grid < 0) return;
    if (hipMemsetAsync((char*)d_ws + WS_CTL, 0, CTL_ZERO_BYTES, stream) != hipSuccess) return;
    Args a{};
    for (int i = 0; i < 20; ++i) a.in[i] = (const float*)d_in[i];
    a.out = (float*)d_out; a.ws = (unsigned char*)d_ws; a.L = 0; a.pad = 0;
#if ONE_LAUNCH
    hipLaunchKernelGGL(hybrid_one, dim3(grid), dim3(512), LDS_BYTES, stream, a);
#else
    for (int L = 0; L < 2; ++L) { a.L = L;
        launch_ph<0>(grid, stream, a); launch_ph<1>(grid, stream, a); launch_ph<2>(grid, stream, a); launch_ph<3>(grid, stream, a); launch_ph<4>(grid, stream, a); launch_ph<5>(grid, stream, a); launch_ph<6>(grid, stream, a);
        launch_ph<7>(grid, stream, a); launch_ph<8>(grid, stream, a); launch_ph<9>(grid, stream, a); launch_ph<10>(grid, stream, a); launch_ph<11>(grid, stream, a); launch_ph<12>(grid, stream, a); }
#endif
}
```
